# Optimizing an MI355X kernel written in HIP

```python
import math
import jax, jax.numpy as jnp
from jax import lax
import numpy as np

D_MODEL = 1024
BATCH = 8
SEQ = 8192
DEPTH = 2

MEM_LEN = 256
BLK = 128
N_BRANCH = 4
BRANCH_W = D_MODEL // 2
HEAD_DIM = 64
SGU_GROUPS = 4
SGU_CHUNK = 128
SGU_GW = BRANCH_W // SGU_GROUPS
LRU_W = BRANCH_W
LRU_HEADS = 4
LRU_HW = LRU_W // LRU_HEADS
CONV_W = 4
LRU_C = 8.0
SWA_HEADS = BRANCH_W // HEAD_DIM
SWA_KV = SWA_HEADS // 4
SWA_WINDOW = 128
FOX_HEADS = BRANCH_W // HEAD_DIM
X_HEADS = 4
X_HEAD_DIM = D_MODEL // 8
D_FF = ((8 * D_MODEL // 3 + 127) // 128) * 128
N_EXPERTS = 8
TOP_K = 2
EPS = 1e-6
IN_SIZES = (BRANCH_W, BRANCH_W, LRU_W, LRU_W, SWA_HEADS * HEAD_DIM, SWA_KV * HEAD_DIM, SWA_KV * HEAD_DIM, FOX_HEADS * HEAD_DIM, FOX_HEADS * HEAD_DIM, FOX_HEADS * HEAD_DIM, FOX_HEADS)
D_IN = sum(IN_SIZES)
N_DENSE = (DEPTH + 1) // 2
N_MOE = DEPTH // 2

kernel_name = 'hybrid_gated_four_mixer_moe_block'


def rms_norm(x, g):
    x32 = x.astype(jnp.float32)
    y = x32 * lax.rsqrt(jnp.mean(x32 * x32, axis=-1, keepdims=True) + EPS)
    return (y * g.astype(jnp.float32)).astype(x.dtype)


def alibi_slopes(n):
    return 2.0 ** (-(8.0 / n) * jnp.arange(1, n + 1, dtype=jnp.float32))


def sgu_mixer(u, v, g_norm, w_s, b_s):
    bsz, seq, _ = v.shape
    v = rms_norm(v, g_norm)
    causal = jnp.tril(jnp.ones((SGU_CHUNK, SGU_CHUNK), dtype=bool))
    w = jnp.where(causal[None], w_s, 0).astype(v.dtype)
    vc = v.reshape(bsz, seq // SGU_CHUNK, SGU_CHUNK, SGU_GROUPS, SGU_GW)
    mixed = jnp.einsum('gts,bcsgd->bctgd', w, vc) + b_s.T[None, None, :, :, None]
    return u * mixed.reshape(bsz, seq, BRANCH_W)


def causal_depthwise_conv(x, w, b):
    ch = x.shape[-1]
    y = lax.conv_general_dilated(x, w[:, None, :].astype(x.dtype), window_strides=(1,), padding=[(CONV_W - 1, 0)], dimension_numbers=('NWC', 'WIO', 'NWC'), feature_group_count=ch)
    return y + b


def rg_lru(x, wa, ba, wx, bx, lam):
    bsz, seq, width = x.shape
    xh = x.reshape(bsz, seq, LRU_HEADS, LRU_HW)
    r = jax.nn.sigmoid(jnp.einsum('bshi,hio->bsho', xh, wa).reshape(bsz, seq, width) + ba)
    i = jax.nn.sigmoid(jnp.einsum('bshi,hio->bsho', xh, wx).reshape(bsz, seq, width) + bx)
    log_a = (-LRU_C * r.astype(jnp.float32)) * jax.nn.softplus(-lam.astype(jnp.float32))
    a = jnp.exp(log_a)
    mult = jnp.sqrt(-jnp.expm1(2.0 * log_a))
    inp = (x * i).astype(jnp.float32) * mult

    def combine(left, right):
        a1, b1 = left
        a2, b2 = right
        return a1 * a2, a2 * b1 + b2

    _, h = lax.associative_scan(combine, (a, inp), axis=1)
    return h.astype(x.dtype)


def swa_sink_attention(q, k, v, sinks):
    bsz, seq, nh, dh = q.shape
    grp = nh // SWA_KV
    nb = seq // BLK
    kp = jnp.pad(k, ((0, 0), (BLK, 0), (0, 0), (0, 0)))
    vp = jnp.pad(v, ((0, 0), (BLK, 0), (0, 0), (0, 0)))
    slopes = alibi_slopes(nh).reshape(SWA_KV, grp)
    sink = sinks.astype(jnp.float32).reshape(SWA_KV, grp)
    s_idx = jnp.arange(2 * BLK)[None, :]
    dist = (jnp.arange(BLK)[:, None] + BLK) - s_idx
    in_win = (dist >= 0) & (dist < SWA_WINDOW)
    alibi = slopes[:, :, None, None] * dist.astype(jnp.float32)
    scale = dh ** -0.5

    def block(i):
        qb = lax.dynamic_slice_in_dim(q, i * BLK, BLK, axis=1).reshape(bsz, BLK, SWA_KV, grp, dh)
        kb = lax.dynamic_slice_in_dim(kp, i * BLK, 2 * BLK, axis=1)
        vb = lax.dynamic_slice_in_dim(vp, i * BLK, 2 * BLK, axis=1)
        s = jnp.einsum('bqkgd,bskd->bkgqs', qb, kb).astype(jnp.float32) * scale - alibi
        valid = in_win & (s_idx + (i - 1) * BLK >= 0)
        s = jnp.where(valid, s, -jnp.inf)
        sink_col = jnp.broadcast_to(sink[None, :, :, None, None], s.shape[:-1] + (1,))
        p = jax.nn.softmax(jnp.concatenate([s, sink_col], axis=-1), axis=-1)[..., :-1]
        o = jnp.einsum('bkgqs,bskd->bqkgd', p.astype(vb.dtype), vb)
        return o.reshape(bsz, BLK, nh * dh)

    out = lax.map(block, jnp.arange(nb))
    return out.transpose(1, 0, 2, 3).reshape(bsz, seq, nh * dh)


def forgetting_attention(q, k, v, f_logit):
    bsz, seq, nh, dh = q.shape
    nb = seq // BLK
    cum = jnp.cumsum(jax.nn.log_sigmoid(f_logit.astype(jnp.float32)), axis=1).transpose(0, 2, 1)
    k_pos = jnp.arange(seq)
    scale = dh ** -0.5

    def block(i):
        qb = lax.dynamic_slice_in_dim(q, i * BLK, BLK, axis=1)
        cq = lax.dynamic_slice_in_dim(cum, i * BLK, BLK, axis=2)
        s = jnp.einsum('bqhd,bkhd->bhqk', qb, k).astype(jnp.float32) * scale + cq[..., None] - cum[:, :, None, :]
        q_pos = i * BLK + jnp.arange(BLK)
        s = jnp.where(k_pos[None, :] <= q_pos[:, None], s, -jnp.inf)
        p = jax.nn.softmax(s, axis=-1)
        o = jnp.einsum('bhqk,bkhd->bqhd', p.astype(v.dtype), v)
        return o.reshape(bsz, BLK, nh * dh)

    out = lax.map(block, jnp.arange(nb))
    return out.transpose(1, 0, 2, 3).reshape(bsz, seq, nh * dh)


def hybrid_mixer(xn, w_in, sgu_g, sgu_w, sgu_b, conv_w, conv_b, rg_wa, rg_ba, rg_wx, rg_bx, rg_lambda, swa_sinks, fox_bf, w_branch, w_gate, b_gate, w_out):
    bsz, seq, _ = xn.shape
    proj = xn @ w_in
    a_u, a_v, b_x, b_y, c_q, c_k, c_v, d_q, d_k, d_v, d_f = jnp.split(proj, np.cumsum(IN_SIZES)[:-1].tolist(), axis=-1)
    o_a = sgu_mixer(jax.nn.gelu(a_u), jax.nn.gelu(a_v), sgu_g, sgu_w, sgu_b)
    o_b = rg_lru(causal_depthwise_conv(b_x, conv_w, conv_b), rg_wa, rg_ba, rg_wx, rg_bx, rg_lambda) * jax.nn.gelu(b_y)
    o_c = swa_sink_attention(c_q.reshape(bsz, seq, SWA_HEADS, HEAD_DIM), c_k.reshape(bsz, seq, SWA_KV, HEAD_DIM), c_v.reshape(bsz, seq, SWA_KV, HEAD_DIM), swa_sinks)
    o_d = forgetting_attention(d_q.reshape(bsz, seq, FOX_HEADS, HEAD_DIM), d_k.reshape(bsz, seq, FOX_HEADS, HEAD_DIM), d_v.reshape(bsz, seq, FOX_HEADS, HEAD_DIM), d_f + fox_bf)
    merged = jnp.zeros_like(xn)
    for br, o in enumerate((o_a, o_b, o_c, o_d)):
        gate = jax.nn.sigmoid(xn @ w_gate[br] + b_gate[br])
        merged = merged + gate * (o @ w_branch[br])
    return merged @ w_out


def memory_cross_attention(hn, mem, g_mem, wq, wkv, wo):
    bsz, seq, _ = hn.shape
    m_len = mem.shape[1]
    q = (hn @ wq).reshape(bsz, seq, X_HEADS, X_HEAD_DIM)
    k, v = jnp.split(rms_norm(mem, g_mem) @ wkv, 2, axis=-1)
    k = k.reshape(bsz, m_len, X_HEADS, X_HEAD_DIM)
    v = v.reshape(bsz, m_len, X_HEADS, X_HEAD_DIM)
    s = jnp.einsum('bshd,bmhd->bhsm', q, k).astype(jnp.float32) * (X_HEAD_DIM ** -0.5)
    p = jax.nn.softmax(s, axis=-1)
    o = jnp.einsum('bhsm,bmhd->bshd', p.astype(v.dtype), v).reshape(bsz, seq, X_HEADS * X_HEAD_DIM)
    return o @ wo


def swiglu(x, w13, w2):
    g, u = jnp.split(x @ w13, 2, axis=-1)
    return (jax.nn.silu(g) * u) @ w2


def moe_ffn(x, w_r, b_r, w13, w2):
    logits = (x @ w_r).astype(jnp.float32) + b_r.astype(jnp.float32)
    top_v, top_i = lax.top_k(logits, TOP_K)
    top_w = jax.nn.softmax(top_v, axis=-1)
    combine = jnp.einsum('bsk,bske->bse', top_w, jax.nn.one_hot(top_i, N_EXPERTS, dtype=jnp.float32)).astype(x.dtype)
    out = jnp.zeros_like(x)
    for e in range(N_EXPERTS):
        out = out + combine[..., e:e + 1] * swiglu(x, w13[e], w2[e])
    return out


def setup_inputs(seed: int = 0) -> dict:
    key = jax.random.key(seed)
    ks = iter(jax.random.split(key, 48))
    f32 = jnp.float32
    L = DEPTH

    def nrm(shape, scale):
        return jax.random.normal(next(ks), shape, f32) * scale

    def gain(shape):
        return 1.0 + 0.05 * jax.random.normal(next(ks), shape, f32)

    x = nrm((BATCH, SEQ, D_MODEL), 1.0)
    mem = nrm((BATCH, MEM_LEN, D_MODEL), 1.0)
    norm_mix = gain((L, D_MODEL))
    w_in = nrm((L, D_MODEL, D_IN), D_MODEL ** -0.5)
    sgu_g = gain((L, BRANCH_W))
    sgu_w = nrm((L, SGU_GROUPS, SGU_CHUNK, SGU_CHUNK), SGU_CHUNK ** -0.5)
    sgu_b = 1.0 + nrm((L, SGU_GROUPS, SGU_CHUNK), 0.1)
    conv_w = nrm((L, CONV_W, LRU_W), CONV_W ** -0.5)
    conv_b = nrm((L, LRU_W), 0.01)
    rg_wa = nrm((L, LRU_HEADS, LRU_HW, LRU_HW), LRU_HW ** -0.5)
    rg_ba = nrm((L, LRU_W), 0.1)
    rg_wx = nrm((L, LRU_HEADS, LRU_HW, LRU_HW), LRU_HW ** -0.5)
    rg_bx = nrm((L, LRU_W), 0.1)
    a_c = jax.random.uniform(next(ks), (L, LRU_W), f32, 0.9, 0.999)
    p_a = a_c ** (1.0 / LRU_C)
    rg_lambda = jnp.log(p_a) - jnp.log1p(-p_a)
    swa_sinks = nrm((L, SWA_HEADS), 0.5)
    fox_bf = jax.random.uniform(next(ks), (L, FOX_HEADS), f32, 2.0, 4.0)
    w_branch = nrm((L, N_BRANCH, BRANCH_W, D_MODEL), BRANCH_W ** -0.5)
    w_gate = nrm((L, N_BRANCH, D_MODEL, D_MODEL), D_MODEL ** -0.5)
    b_gate = nrm((L, N_BRANCH, D_MODEL), 0.1)
    w_out = nrm((L, D_MODEL, D_MODEL), D_MODEL ** -0.5)
    norm_cross = gain((L, D_MODEL))
    norm_mem = gain((L, D_MODEL))
    wq_c = nrm((L, D_MODEL, X_HEADS * X_HEAD_DIM), D_MODEL ** -0.5)
    wkv_c = nrm((L, D_MODEL, 2 * X_HEADS * X_HEAD_DIM), D_MODEL ** -0.5)
    wo_c = nrm((L, X_HEADS * X_HEAD_DIM, D_MODEL), (X_HEADS * X_HEAD_DIM) ** -0.5)
    norm_ffn = gain((L, D_MODEL))
    dense_w13 = nrm((N_DENSE, D_MODEL, 2 * D_FF), D_MODEL ** -0.5)
    dense_w2 = nrm((N_DENSE, D_FF, D_MODEL), D_FF ** -0.5)
    router_w = nrm((N_MOE, D_MODEL, N_EXPERTS), D_MODEL ** -0.5)
    router_b = nrm((N_MOE, N_EXPERTS), 0.01)
    moe_w13 = nrm((N_MOE, N_EXPERTS, D_MODEL, 2 * D_FF), D_MODEL ** -0.5)
    moe_w2 = nrm((N_MOE, N_EXPERTS, D_FF, D_MODEL), D_FF ** -0.5)
    norm_final = gain((D_MODEL,))
    return dict(x=x, mem=mem, norm_mix=norm_mix, w_in=w_in, sgu_g=sgu_g, sgu_w=sgu_w, sgu_b=sgu_b, conv_w=conv_w, conv_b=conv_b, rg_wa=rg_wa, rg_ba=rg_ba, rg_wx=rg_wx, rg_bx=rg_bx, rg_lambda=rg_lambda, swa_sinks=swa_sinks, fox_bf=fox_bf, w_branch=w_branch, w_gate=w_gate, b_gate=b_gate, w_out=w_out, norm_cross=norm_cross, norm_mem=norm_mem, wq_c=wq_c, wkv_c=wkv_c, wo_c=wo_c, norm_ffn=norm_ffn, dense_w13=dense_w13, dense_w2=dense_w2, router_w=router_w, router_b=router_b, moe_w13=moe_w13, moe_w2=moe_w2, norm_final=norm_final)


def reference(x, mem, norm_mix, w_in, sgu_g, sgu_w, sgu_b, conv_w, conv_b, rg_wa, rg_ba, rg_wx, rg_bx, rg_lambda, swa_sinks, fox_bf, w_branch, w_gate, b_gate, w_out, norm_cross, norm_mem, wq_c, wkv_c, wo_c, norm_ffn, dense_w13, dense_w2, router_w, router_b, moe_w13, moe_w2, norm_final):
    h = x
    for l in range(DEPTH):
        h = h + hybrid_mixer(rms_norm(h, norm_mix[l]), w_in[l], sgu_g[l], sgu_w[l], sgu_b[l], conv_w[l], conv_b[l], rg_wa[l], rg_ba[l], rg_wx[l], rg_bx[l], rg_lambda[l], swa_sinks[l], fox_bf[l], w_branch[l], w_gate[l], b_gate[l], w_out[l])
        h = h + memory_cross_attention(rms_norm(h, norm_cross[l]), mem, norm_mem[l], wq_c[l], wkv_c[l], wo_c[l])
        hn = rms_norm(h, norm_ffn[l])
        if l % 2 == 0:
            h = h + swiglu(hn, dense_w13[l // 2], dense_w2[l // 2])
        else:
            h = h + moe_ffn(hn, router_w[l // 2], router_b[l // 2], moe_w13[l // 2], moe_w2[l // 2])
    return rms_norm(h, norm_final)
```

```cpp
#include <hip/hip_runtime.h>
#include <cstdio>
#include <cstdint>
namespace pg8 {
#define PG8_LAS __attribute__((address_space(3)))
typedef unsigned short bf16_t;
typedef short bf16x8 __attribute__((ext_vector_type(8)));
typedef float f32x4 __attribute__((ext_vector_type(4)));
typedef float f32x2 __attribute__((ext_vector_type(2)));
typedef unsigned u32x4 __attribute__((ext_vector_type(4)));
typedef unsigned u32x2 __attribute__((ext_vector_type(2)));
constexpr int BM = 256, BK = 64, HALF = 128, HTB = HALF * BK * 2  , STAGE_BYTES = 8 * HTB, NXCD = 8, WGM = 8;

__host__ __device__ __forceinline__ int lds_byte(int r, int c) { const int st = (r >> 4) * 2 + (c >> 5), rr = r & 15, cc = c & 31, ob = rr * 64 + cc * 2; return st * 1024 + (ob ^ (((ob >> 9) & 1) << 5)); }
__host__ __device__ __forceinline__ void stage_rc(int b, int& R, int& C) { const int st = b / 1024, sb = b % 1024, swz = sb ^ (((sb >> 9) & 1) << 5); R = (st >> 1) * 16 + swz / 64; C = (st & 1) * 32 + (swz % 64) / 2; }
__host__ __device__ __forceinline__ int perm32(int rho) { const int n = rho >> 4, i = rho & 15; return 8 * (i >> 2) + 4 * n + (i & 3); }

struct Unit { int pm, pn, e; };
template <class E, class = void> struct zeroes_of { static constexpr bool value = false; };
template <class E> struct zeroes_of<E, decltype((void)E::ZEROES)> { static constexpr bool value = E::ZEROES; };
struct Gemm { const bf16_t* A; int lda; const bf16_t* Bt; long bes; int K; };

struct StaticOrder {
    int nM, nN, nwg, G, c, ediv;
    __device__ __forceinline__ void init(int M, int N, int G_, int c_, int ediv_ = 0) { nM = M / BM; nN = N / BM; nwg = nM * nN; G = G_; c = c_; ediv = ediv_; }
    __device__ __forceinline__ bool next(int i, Unit& u) const {
        const long L = (long)i * G + c; if (L >= nwg) return false;
        int wgid = (int)L; { const int q = nwg / NXCD, r = nwg % NXCD, xcd = wgid % NXCD, off = wgid / NXCD; wgid = (xcd < r ? xcd * (q + 1) : r * (q + 1) + (xcd - r) * q) + off; }
        const int nig = WGM * nN, gid = wgid / nig, fm = gid * WGM, gsz = (nM - fm) < WGM ? (nM - fm) : WGM;
        u.pm = fm + ((wgid % nig) % gsz); u.pn = (wgid % nig) / gsz; u.e = ediv ? u.pm / ediv : 0; return true;
    }
};
struct OneUnit {
    int idx, ediv;
    __device__ __forceinline__ bool next(int i, Unit& u) const { if (i != 0) return false; u.pn = idx & 3; u.pm = idx >> 2; u.e = ediv ? u.pm / ediv : 0; return true; }
};
struct TableOrder {
    int nM, nN, nwg, G, c; const int* etab;
    __device__ __forceinline__ void init(int nM_, int N, int G_, int c_, const int* etab_) { nM = nM_; nN = N / BM; nwg = nM * nN; G = G_; c = c_; etab = etab_; }
    __device__ __forceinline__ bool next(int i, Unit& u) const {
        const long L = (long)i * G + c; if (L >= nwg) return false;
        int wgid = (int)L; { const int q = nwg / NXCD, r = nwg % NXCD, xcd = wgid % NXCD, off = wgid / NXCD; wgid = (xcd < r ? xcd * (q + 1) : r * (q + 1) + (xcd - r) * q) + off; }
        const int nig = WGM * nN, gid = wgid / nig, fm = gid * WGM, gsz = (nM - fm) < WGM ? (nM - fm) : WGM;
        u.pm = fm + ((wgid % nig) % gsz); u.pn = (wgid % nig) / gsz; u.e = __builtin_amdgcn_readfirstlane(etab[u.pm]); return true;
    }
};

typedef float f32x2_cv __attribute__((ext_vector_type(2))); typedef __bf16 bf16x2_cv __attribute__((ext_vector_type(2)));
__device__ __forceinline__ unsigned cvt_pk_bf16(float lo, float hi) { const f32x2_cv v = {lo, hi}; const bf16x2_cv b = __builtin_convertvector(v, bf16x2_cv); return __builtin_bit_cast(unsigned, b); }
__device__ __forceinline__ float bf_lo(unsigned w) { return __uint_as_float(w << 16); }
__device__ __forceinline__ float bf_hi(unsigned w) { return __uint_as_float(w & 0xffff0000u); }
__device__ __forceinline__ float fast_sigmoid(float x) { return __builtin_amdgcn_rcpf(1.0f + __builtin_amdgcn_exp2f(-1.4426950408889634f * x)); }
__device__ __forceinline__ float gelu_tanh(float x) { const float u = x * (1.0f + 0.044715f * x * x); return x * __builtin_amdgcn_rcpf(1.0f + __builtin_amdgcn_exp2f(-2.302208198f * u)); }
__device__ __forceinline__ u32x4 pack8(const f32x4& v0, const f32x4& v1) { u32x4 w; w.x = cvt_pk_bf16(v0[0], v0[1]); w.y = cvt_pk_bf16(v0[2], v0[3]); w.z = cvt_pk_bf16(v1[0], v1[1]); w.w = cvt_pk_bf16(v1[2], v1[3]); return w; }

template <class Epi, class Sched, bool ALIGN_EPI>
__device__ __forceinline__ void gemm_phase(PG8_LAS unsigned char* lds, const Gemm g, const Sched& S, const Epi& E) {
    int tid_ = threadIdx.x; asm volatile("" : "+v"(tid_));
    const int tid = tid_, wid = __builtin_amdgcn_readfirstlane(tid >> 6), lane = tid & 63, wr = wid >> 2, wc = wid & 3, fr = lane & 15, fq = lane >> 4;
    const int K = g.K, nt = K / BK, lda = g.lda;
    unsigned voffA[2], voffB[2];
#pragma unroll
    for (int i = 0; i < 2; ++i) { int R, C; stage_rc(tid * 16 + i * 8192, R, C); const int Rb = (R & ~31) + perm32(R & 31);
        voffA[i] = (unsigned)(R * lda + C) * 2u; voffB[i] = (unsigned)(Rb * K + C) * 2u; }
    const size_t kstep = (size_t)(BK * 2);
    const size_t hstepA = (size_t)HALF * lda * 2, hstepB = (size_t)HALF * K * 2;
    const size_t tstepA = 2 * hstepA, tstepB = 2 * hstepB;
    const size_t estepB = (size_t)g.bes * 2;
    const unsigned ldsw = (unsigned)wid * 1024u;
    const int aoff = lds_byte(wr * 64 + fr, fq * 8), boff = lds_byte(wc * 32 + fr, fq * 8);
#define PG8_SA(b, h) (((b) * 2 + (h)) * HTB)
#define PG8_SB(b, h) ((4 + (b) * 2 + (h)) * HTB)
#define PG8_STAGE(bufoff, gbase, voff) do { _Pragma("unroll") for (int _i = 0; _i < 2; ++_i) \
        __builtin_amdgcn_global_load_lds((const unsigned*)((const char*)(gbase) + (voff)[_i]), (PG8_LAS unsigned*)(lds + (bufoff) + ldsw + _i * 8192), 16, 0, 0); } while (0)
#define PG8_LDA(dst, b, h) do { _Pragma("unroll") for (int m = 0; m < 4; ++m) _Pragma("unroll") for (int k = 0; k < 2; ++k) dst[m][k] = *(const PG8_LAS bf16x8*)(lds + PG8_SA(b, h) + aoff + m * 2048 + k * 1024); } while (0)
#define PG8_LDB(dst, b, h) do { _Pragma("unroll") for (int n = 0; n < 2; ++n) _Pragma("unroll") for (int k = 0; k < 2; ++k) dst[n][k] = *(const PG8_LAS bf16x8*)(lds + PG8_SB(b, h) + boff + n * 2048 + k * 1024); } while (0)
#define PG8_MMA(ai, bj, At, Bt) do { __builtin_amdgcn_s_setprio(1); _Pragma("unroll") for (int m = 0; m < 4; ++m) _Pragma("unroll") for (int n = 0; n < 2; ++n) _Pragma("unroll") for (int k = 0; k < 2; ++k) \
        acc[ai][bj][m][n] = __builtin_amdgcn_mfma_f32_16x16x32_bf16(Bt[n][k], At[m][k], acc[ai][bj][m][n], 0, 0, 0); __builtin_amdgcn_s_setprio(0); } while (0)
#define PG8_WAIT_V(n) asm volatile("s_waitcnt vmcnt(" #n ")" ::: "memory")
#define PG8_WAIT_L(n) asm volatile("s_waitcnt lgkmcnt(" #n ")" ::: "memory")
#define PG8_BAR __builtin_amdgcn_s_barrier()
#define PG8_SCHED __builtin_amdgcn_sched_barrier(0)
    Unit cur, nxt; int ui = 0;
    if (!S.next(0, cur)) return;
    f32x4 acc[2][2][4][2];
#pragma unroll
    for (int a = 0; a < 2; ++a)
#pragma unroll
        for (int b = 0; b < 2; ++b)
#pragma unroll
            for (int m = 0; m < 4; ++m)
#pragma unroll
                for (int n = 0; n < 2; ++n) acc[a][b][m][n] = (f32x4){0.f, 0.f, 0.f, 0.f};
    bf16x8 At[4][2], B0[2][2], B1[2][2];
    const char* cA = (const char*)g.A + (size_t)cur.pm * tstepA; const char* cB = (const char*)g.Bt + (size_t)cur.e * estepB + (size_t)cur.pn * tstepB;
    PG8_STAGE(PG8_SB(0, 0), cB, voffB); PG8_STAGE(PG8_SB(0, 1), cB + hstepB, voffB); PG8_STAGE(PG8_SA(0, 0), cA, voffA); PG8_STAGE(PG8_SA(0, 1), cA + hstepA, voffA);
    if (wr == 1) PG8_BAR;
    PG8_WAIT_V(2); PG8_BAR;
    PG8_STAGE(PG8_SB(1, 0), cB + kstep, voffB); PG8_STAGE(PG8_SA(1, 0), cA + kstep, voffA); PG8_STAGE(PG8_SB(1, 1), cB + hstepB + kstep, voffB);
    PG8_WAIT_V(6); PG8_BAR;
    for (;;) {
        const bool has_next = S.next(ui + 1, nxt);
        const char* nA = has_next ? (const char*)g.A + (size_t)nxt.pm * tstepA : cA; const char* nB = has_next ? (const char*)g.Bt + (size_t)nxt.e * estepB + (size_t)nxt.pn * tstepB : cB;
        for (int t = 0; t < nt; t += 2) {
            const bool last = (t == nt - 2);
            const char* a1 = cA + (size_t)(t + 1) * kstep;
            const char* a2 = last ? nA : cA + (size_t)(t + 2) * kstep; const char* b2 = last ? nB : cB + (size_t)(t + 2) * kstep;
            const char* a3 = a2 + kstep; const char* b3 = b2 + kstep;
            PG8_LDB(B0, 0, 0); PG8_LDB(B1, 0, 1); PG8_SCHED; PG8_LDA(At, 0, 0); PG8_STAGE(PG8_SA(1, 1), a1 + hstepA, voffA);
            PG8_WAIT_V(8); PG8_WAIT_L(0); PG8_BAR; PG8_MMA(0, 0, At, B0); PG8_MMA(0, 1, At, B1); PG8_BAR; PG8_SCHED;
            PG8_LDA(At, 0, 1); PG8_STAGE(PG8_SB(0, 0), b2, voffB); PG8_STAGE(PG8_SB(0, 1), b2 + hstepB, voffB); PG8_STAGE(PG8_SA(0, 0), a2, voffA);
            PG8_WAIT_V(8); PG8_WAIT_L(0); PG8_BAR; PG8_MMA(1, 0, At, B0); PG8_MMA(1, 1, At, B1); PG8_BAR; PG8_SCHED;
            PG8_LDB(B0, 1, 0); PG8_LDB(B1, 1, 1); PG8_SCHED; PG8_LDA(At, 1, 0); PG8_STAGE(PG8_SA(0, 1), a2 + hstepA, voffA);
            PG8_WAIT_V(8); PG8_WAIT_L(0); PG8_BAR; PG8_MMA(0, 0, At, B0); PG8_MMA(0, 1, At, B1); PG8_BAR; PG8_SCHED;
            PG8_LDA(At, 1, 1); PG8_STAGE(PG8_SB(1, 0), b3, voffB); PG8_STAGE(PG8_SB(1, 1), b3 + hstepB, voffB); PG8_STAGE(PG8_SA(1, 0), a3, voffA);
            PG8_WAIT_V(8); PG8_WAIT_L(0); PG8_BAR; PG8_MMA(1, 0, At, B0); PG8_MMA(1, 1, At, B1); PG8_BAR; PG8_SCHED;
        }
        if constexpr (ALIGN_EPI) { if (wr == 0) PG8_BAR; }
        E(acc, cur, wr, wc, fr, fq);
        if (!has_next) break;
        if constexpr (!zeroes_of<Epi>::value) {
#pragma unroll
        for (int a = 0; a < 2; ++a)
#pragma unroll
            for (int b = 0; b < 2; ++b)
#pragma unroll
                for (int m = 0; m < 4; ++m)
#pragma unroll
                    for (int n = 0; n < 2; ++n) acc[a][b][m][n] = (f32x4){0.f, 0.f, 0.f, 0.f};
        }
        cur = nxt; cA = nA; cB = nB; ++ui;
        if constexpr (ALIGN_EPI) { if (wr == 1) PG8_BAR; }
    }
    PG8_WAIT_V(0);
    if constexpr (!ALIGN_EPI) { if (wr == 0) PG8_BAR; }
    PG8_BAR;
#undef PG8_SA
#undef PG8_SB
#undef PG8_STAGE
#undef PG8_LDA
#undef PG8_LDB
#undef PG8_MMA
#undef PG8_WAIT_V
#undef PG8_WAIT_L
#undef PG8_BAR
#undef PG8_SCHED
}

template <class Epi, class Sched, bool ALIGN_EPI>
__device__ __forceinline__ void gemm_phase_ga(PG8_LAS unsigned char* lds, const Gemm g, const Sched& S, const Epi& E, const int* rowtab) {
    int tid_ = threadIdx.x; asm volatile("" : "+v"(tid_));
    const int tid = tid_, wid = __builtin_amdgcn_readfirstlane(tid >> 6), lane = tid & 63, wr = wid >> 2, wc = wid & 3, fr = lane & 15, fq = lane >> 4;
    const int K = g.K, nt = K / BK, lda = g.lda;
    unsigned voffB[2], vc[2][2], vn[2][2]; int RA[2], CA[2];
#pragma unroll
    for (int i = 0; i < 2; ++i) { int R, C; stage_rc(tid * 16 + i * 8192, R, C); const int Rb = (R & ~31) + perm32(R & 31);
        RA[i] = R; CA[i] = C; voffB[i] = (unsigned)(Rb * K + C) * 2u; }
#define PG8_ROWS(dst, pm_) do { const int* rt_ = rowtab + (pm_) * BM; const int t00_ = rt_[RA[0]], t01_ = rt_[RA[1]], t10_ = rt_[HALF + RA[0]], t11_ = rt_[HALF + RA[1]];     \
        dst[0][0] = (unsigned)((t00_ < 0 ? 0 : t00_) * lda + CA[0]) * 2u; dst[0][1] = (unsigned)((t01_ < 0 ? 0 : t01_) * lda + CA[1]) * 2u; dst[1][0] = (unsigned)((t10_ < 0 ? 0 : t10_) * lda + CA[0]) * 2u; dst[1][1] = (unsigned)((t11_ < 0 ? 0 : t11_) * lda + CA[1]) * 2u; } while (0)
#define PG8_SELV(dst, h_) unsigned dst[2]; dst[0] = last ? vn[h_][0] : vc[h_][0]; dst[1] = last ? vn[h_][1] : vc[h_][1]
    const size_t kstep = (size_t)(BK * 2);
    const size_t hstepA = (size_t)HALF * lda * 2, hstepB = (size_t)HALF * K * 2;
    const size_t tstepA = 2 * hstepA, tstepB = 2 * hstepB;
    const size_t estepB = (size_t)g.bes * 2;
    const unsigned ldsw = (unsigned)wid * 1024u;
    const int aoff = lds_byte(wr * 64 + fr, fq * 8), boff = lds_byte(wc * 32 + fr, fq * 8);
#define PG8_SA(b, h) (((b) * 2 + (h)) * HTB)
#define PG8_SB(b, h) ((4 + (b) * 2 + (h)) * HTB)
#define PG8_STAGE(bufoff, gbase, voff) do { _Pragma("unroll") for (int _i = 0; _i < 2; ++_i) \
        __builtin_amdgcn_global_load_lds((const unsigned*)((const char*)(gbase) + (voff)[_i]), (PG8_LAS unsigned*)(lds + (bufoff) + ldsw + _i * 8192), 16, 0, 0); } while (0)
#define PG8_LDA(dst, b, h) do { _Pragma("unroll") for (int m = 0; m < 4; ++m) _Pragma("unroll") for (int k = 0; k < 2; ++k) dst[m][k] = *(const PG8_LAS bf16x8*)(lds + PG8_SA(b, h) + aoff + m * 2048 + k * 1024); } while (0)
#define PG8_LDB(dst, b, h) do { _Pragma("unroll") for (int n = 0; n < 2; ++n) _Pragma("unroll") for (int k = 0; k < 2; ++k) dst[n][k] = *(const PG8_LAS bf16x8*)(lds + PG8_SB(b, h) + boff + n * 2048 + k * 1024); } while (0)
#define PG8_MMA(ai, bj, At, Bt) do { __builtin_amdgcn_s_setprio(1); _Pragma("unroll") for (int m = 0; m < 4; ++m) _Pragma("unroll") for (int n = 0; n < 2; ++n) _Pragma("unroll") for (int k = 0; k < 2; ++k) \
        acc[ai][bj][m][n] = __builtin_amdgcn_mfma_f32_16x16x32_bf16(Bt[n][k], At[m][k], acc[ai][bj][m][n], 0, 0, 0); __builtin_amdgcn_s_setprio(0); } while (0)
#define PG8_WAIT_V(n) asm volatile("s_waitcnt vmcnt(" #n ")" ::: "memory")
#define PG8_WAIT_L(n) asm volatile("s_waitcnt lgkmcnt(" #n ")" ::: "memory")
#define PG8_BAR __builtin_amdgcn_s_barrier()
#define PG8_SCHED __builtin_amdgcn_sched_barrier(0)
    Unit cur, nxt; int ui = 0;
    if (!S.next(0, cur)) return;
    f32x4 acc[2][2][4][2];
#pragma unroll
    for (int a = 0; a < 2; ++a)
#pragma unroll
        for (int b = 0; b < 2; ++b)
#pragma unroll
            for (int m = 0; m < 4; ++m)
#pragma unroll
                for (int n = 0; n < 2; ++n) acc[a][b][m][n] = (f32x4){0.f, 0.f, 0.f, 0.f};
    bf16x8 At[4][2], B0[2][2], B1[2][2];
    const char* const cA = (const char*)g.A; const char* cB = (const char*)g.Bt + (size_t)cur.e * estepB + (size_t)cur.pn * tstepB;
    PG8_ROWS(vc, cur.pm);
    PG8_STAGE(PG8_SB(0, 0), cB, voffB); PG8_STAGE(PG8_SB(0, 1), cB + hstepB, voffB); PG8_STAGE(PG8_SA(0, 0), cA, vc[0]); PG8_STAGE(PG8_SA(0, 1), cA, vc[1]);
    if (wr == 1) PG8_BAR;
    PG8_WAIT_V(2); PG8_BAR;
    PG8_STAGE(PG8_SB(1, 0), cB + kstep, voffB); PG8_STAGE(PG8_SA(1, 0), cA + kstep, vc[0]); PG8_STAGE(PG8_SB(1, 1), cB + hstepB + kstep, voffB);
    PG8_WAIT_V(6); PG8_BAR;
    for (;;) {
        const bool has_next = S.next(ui + 1, nxt);
        const char* nB = has_next ? (const char*)g.Bt + (size_t)nxt.e * estepB + (size_t)nxt.pn * tstepB : cB;
        { const int npm = has_next ? nxt.pm : cur.pm; PG8_ROWS(vn, npm); }
        for (int t = 0; t < nt; t += 2) {
            const bool last = (t == nt - 2);
            const char* a1 = cA + (size_t)(t + 1) * kstep;
            const char* a2 = last ? cA : cA + (size_t)(t + 2) * kstep; const char* b2 = last ? nB : cB + (size_t)(t + 2) * kstep;
            PG8_SELV(v0, 0); PG8_SELV(v1, 1);
            const char* a3 = a2 + kstep; const char* b3 = b2 + kstep;
            PG8_LDB(B0, 0, 0); PG8_LDB(B1, 0, 1); PG8_SCHED; PG8_LDA(At, 0, 0); PG8_STAGE(PG8_SA(1, 1), a1, vc[1]);
            PG8_WAIT_V(8); PG8_WAIT_L(0); PG8_BAR; PG8_MMA(0, 0, At, B0); PG8_MMA(0, 1, At, B1); PG8_BAR; PG8_SCHED;
            PG8_LDA(At, 0, 1); PG8_STAGE(PG8_SB(0, 0), b2, voffB); PG8_STAGE(PG8_SB(0, 1), b2 + hstepB, voffB); PG8_STAGE(PG8_SA(0, 0), a2, v0);
            PG8_WAIT_V(8); PG8_WAIT_L(0); PG8_BAR; PG8_MMA(1, 0, At, B0); PG8_MMA(1, 1, At, B1); PG8_BAR; PG8_SCHED;
            PG8_LDB(B0, 1, 0); PG8_LDB(B1, 1, 1); PG8_SCHED; PG8_LDA(At, 1, 0); PG8_STAGE(PG8_SA(0, 1), a2, v1);
            PG8_WAIT_V(8); PG8_WAIT_L(0); PG8_BAR; PG8_MMA(0, 0, At, B0); PG8_MMA(0, 1, At, B1); PG8_BAR; PG8_SCHED;
            PG8_LDA(At, 1, 1); PG8_STAGE(PG8_SB(1, 0), b3, voffB); PG8_STAGE(PG8_SB(1, 1), b3 + hstepB, voffB); PG8_STAGE(PG8_SA(1, 0), a3, v0);
            PG8_WAIT_V(8); PG8_WAIT_L(0); PG8_BAR; PG8_MMA(1, 0, At, B0); PG8_MMA(1, 1, At, B1); PG8_BAR; PG8_SCHED;
        }
        if constexpr (ALIGN_EPI) { if (wr == 0) PG8_BAR; }
        E(acc, cur, wr, wc, fr, fq);
        if (!has_next) break;
        if constexpr (!zeroes_of<Epi>::value) {
#pragma unroll
        for (int a = 0; a < 2; ++a)
#pragma unroll
            for (int b = 0; b < 2; ++b)
#pragma unroll
                for (int m = 0; m < 4; ++m)
#pragma unroll
                    for (int n = 0; n < 2; ++n) acc[a][b][m][n] = (f32x4){0.f, 0.f, 0.f, 0.f};
        }
        cur = nxt; cB = nB; ++ui;
#pragma unroll
        for (int h_ = 0; h_ < 2; ++h_) { vc[h_][0] = vn[h_][0]; vc[h_][1] = vn[h_][1]; }
        if constexpr (ALIGN_EPI) { if (wr == 1) PG8_BAR; }
    }
    PG8_WAIT_V(0);
    if constexpr (!ALIGN_EPI) { if (wr == 0) PG8_BAR; }
    PG8_BAR;
#undef PG8_ROWS
#undef PG8_SELV
#undef PG8_SA
#undef PG8_SB
#undef PG8_STAGE
#undef PG8_LDA
#undef PG8_LDB
#undef PG8_MMA
#undef PG8_WAIT_V
#undef PG8_WAIT_L
#undef PG8_BAR
#undef PG8_SCHED
}

struct GBParams { const bf16_t* XN; const bf16_t* PJ; int lda1; int col0, col1, col2, col3; const bf16_t* WG; const bf16_t* WB; };
struct GBUnit { int pm, pn, sub; };
template <class Epi>
__device__ __forceinline__ void gemm_gb_phase(PG8_LAS unsigned char* lds, const GBParams p, const StaticOrder& S, const Epi& E) {
    int tid_ = threadIdx.x; asm volatile("" : "+v"(tid_));
    const int tid = tid_, wid = __builtin_amdgcn_readfirstlane(tid >> 6), lane = tid & 63, wr = wid >> 2, wc = wid & 3, fr = lane & 15, fq = lane >> 4;
    constexpr int KP = 1024;
    unsigned voffA0[2], voffA1[2], voffB[2];
#pragma unroll
    for (int i = 0; i < 2; ++i) { int R, C; stage_rc(tid * 16 + i * 8192, R, C); const int Rb = (R & ~31) + perm32(R & 31);
        voffA0[i] = (unsigned)(R * KP + C) * 2u; voffA1[i] = (unsigned)(R * p.lda1 + C) * 2u; voffB[i] = (unsigned)(Rb * KP + C) * 2u; }
    const size_t kstep = (size_t)(BK * 2);
    const size_t hstepB = (size_t)HALF * KP * 2, tstepB = 2 * hstepB;
    const unsigned ldsw = (unsigned)wid * 1024u;
    const int aoff = lds_byte(wr * 64 + fr, fq * 8), boff = lds_byte(wc * 32 + fr, fq * 8);
#define PG8_SA(b, h) (((b) * 2 + (h)) * HTB)
#define PG8_SB(b, h) ((4 + (b) * 2 + (h)) * HTB)
#define PG8_STAGE(bufoff, gbase, voff) do { _Pragma("unroll") for (int _i = 0; _i < 2; ++_i) \
        __builtin_amdgcn_global_load_lds((const unsigned*)((const char*)(gbase) + (voff)[_i]), (PG8_LAS unsigned*)(lds + (bufoff) + ldsw + _i * 8192), 16, 0, 0); } while (0)
#define PG8_LDA(dst, b, h) do { _Pragma("unroll") for (int m = 0; m < 4; ++m) _Pragma("unroll") for (int k = 0; k < 2; ++k) dst[m][k] = *(const PG8_LAS bf16x8*)(lds + PG8_SA(b, h) + aoff + m * 2048 + k * 1024); } while (0)
#define PG8_LDB(dst, b, h) do { _Pragma("unroll") for (int n = 0; n < 2; ++n) _Pragma("unroll") for (int k = 0; k < 2; ++k) dst[n][k] = *(const PG8_LAS bf16x8*)(lds + PG8_SB(b, h) + boff + n * 2048 + k * 1024); } while (0)
#define PG8_MMA(ai, bj, At, Bt) do { __builtin_amdgcn_s_setprio(1); _Pragma("unroll") for (int m = 0; m < 4; ++m) _Pragma("unroll") for (int n = 0; n < 2; ++n) _Pragma("unroll") for (int k = 0; k < 2; ++k) \
        acc[ai][bj][m][n] = __builtin_amdgcn_mfma_f32_16x16x32_bf16(Bt[n][k], At[m][k], acc[ai][bj][m][n], 0, 0, 0); __builtin_amdgcn_s_setprio(0); } while (0)
#define PG8_WAIT_V(n) asm volatile("s_waitcnt vmcnt(" #n ")" ::: "memory")
#define PG8_WAIT_L(n) asm volatile("s_waitcnt lgkmcnt(" #n ")" ::: "memory")
#define PG8_BAR __builtin_amdgcn_s_barrier()
#define PG8_SCHED __builtin_amdgcn_sched_barrier(0)
#define GB_NEXT(idx, u, ok) do { Unit t_; ok = S.next((idx) >> 3, t_); u.pm = t_.pm; u.pn = t_.pn; u.sub = (idx) & 7; } while (0)
#define GB_OPS(u, Ap, Bp, hA, sel, ntv) do { const int br_ = (u).sub >> 1; sel = (u).sub & 1; ntv = sel ? 8 : 16; \
        const int col_ = (br_ == 0) ? p.col0 : (br_ == 1) ? p.col1 : (br_ == 2) ? p.col2 : p.col3; \
        hA = sel ? (size_t)HALF * p.lda1 * 2 : (size_t)HALF * KP * 2; \
        Ap = sel ? (const char*)(p.PJ + col_) + (size_t)(u).pm * 2 * hA : (const char*)p.XN + (size_t)(u).pm * 2 * hA; \
        Bp = (const char*)(sel ? p.WB : p.WG) + ((size_t)br_ * KP * KP + (size_t)(u).pn * BM * KP) * 2; } while (0)
#define GB_VA(sel, i) ((sel) ? voffA1[i] : voffA0[i])
#define GB_STAGE_A(bufoff, gbase, sel) do { _Pragma("unroll") for (int _i = 0; _i < 2; ++_i) \
        __builtin_amdgcn_global_load_lds((const unsigned*)((const char*)(gbase) + GB_VA(sel, _i)), (PG8_LAS unsigned*)(lds + (bufoff) + ldsw + _i * 8192), 16, 0, 0); } while (0)
    GBUnit cur, nxt; int ui = 0; bool ok0;
    GB_NEXT(0, cur, ok0);
    if (!ok0) return;
    f32x4 acc[2][2][4][2];
#pragma unroll
    for (int a = 0; a < 2; ++a)
#pragma unroll
        for (int b = 0; b < 2; ++b)
#pragma unroll
            for (int m = 0; m < 4; ++m)
#pragma unroll
                for (int n = 0; n < 2; ++n) acc[a][b][m][n] = (f32x4){0.f, 0.f, 0.f, 0.f};
    bf16x8 At[4][2], B0[2][2], B1[2][2];
    const char* cA; const char* cB; size_t chA; int csel, cnt;
    GB_OPS(cur, cA, cB, chA, csel, cnt);
    PG8_STAGE(PG8_SB(0, 0), cB, voffB); PG8_STAGE(PG8_SB(0, 1), cB + hstepB, voffB); GB_STAGE_A(PG8_SA(0, 0), cA, csel); GB_STAGE_A(PG8_SA(0, 1), cA + chA, csel);
    if (wr == 1) PG8_BAR;
    PG8_WAIT_V(2); PG8_BAR;
    PG8_STAGE(PG8_SB(1, 0), cB + kstep, voffB); GB_STAGE_A(PG8_SA(1, 0), cA + kstep, csel); PG8_STAGE(PG8_SB(1, 1), cB + hstepB + kstep, voffB);
    PG8_WAIT_V(6); PG8_BAR;
    for (;;) {
        bool has_next; GB_NEXT(ui + 1, nxt, has_next);
        const char* nA = cA; const char* nB = cB; size_t nhA = chA; int nsel = csel, nnt = cnt;
        if (has_next) GB_OPS(nxt, nA, nB, nhA, nsel, nnt);
        for (int t = 0; t < cnt; t += 2) {
            const bool last = (t == cnt - 2);
            const char* a1 = cA + (size_t)(t + 1) * kstep;
            const char* a2 = last ? nA : cA + (size_t)(t + 2) * kstep; const char* b2 = last ? nB : cB + (size_t)(t + 2) * kstep;
            const char* a3 = a2 + kstep; const char* b3 = b2 + kstep;
            const int xsel = last ? nsel : csel; const size_t xhA = last ? nhA : chA;
            PG8_LDB(B0, 0, 0); PG8_LDB(B1, 0, 1); PG8_SCHED; PG8_LDA(At, 0, 0); GB_STAGE_A(PG8_SA(1, 1), a1 + chA, csel);
            PG8_WAIT_V(8); PG8_WAIT_L(0); PG8_BAR; PG8_MMA(0, 0, At, B0); PG8_MMA(0, 1, At, B1); PG8_BAR; PG8_SCHED;
            PG8_LDA(At, 0, 1); PG8_STAGE(PG8_SB(0, 0), b2, voffB); PG8_STAGE(PG8_SB(0, 1), b2 + hstepB, voffB); GB_STAGE_A(PG8_SA(0, 0), a2, xsel);
            PG8_WAIT_V(8); PG8_WAIT_L(0); PG8_BAR; PG8_MMA(1, 0, At, B0); PG8_MMA(1, 1, At, B1); PG8_BAR; PG8_SCHED;
            PG8_LDB(B0, 1, 0); PG8_LDB(B1, 1, 1); PG8_SCHED; PG8_LDA(At, 1, 0); GB_STAGE_A(PG8_SA(0, 1), a2 + xhA, xsel);
            PG8_WAIT_V(8); PG8_WAIT_L(0); PG8_BAR; PG8_MMA(0, 0, At, B0); PG8_MMA(0, 1, At, B1); PG8_BAR; PG8_SCHED;
            PG8_LDA(At, 1, 1); PG8_STAGE(PG8_SB(1, 0), b3, voffB); PG8_STAGE(PG8_SB(1, 1), b3 + hstepB, voffB); GB_STAGE_A(PG8_SA(1, 0), a3, xsel);
            PG8_WAIT_V(8); PG8_WAIT_L(0); PG8_BAR; PG8_MMA(1, 0, At, B0); PG8_MMA(1, 1, At, B1); PG8_BAR; PG8_SCHED;
        }
        if (wr == 0) PG8_BAR;
        E(acc, cur, wr, wc, fr, fq);
        if (!has_next) break;
        if constexpr (!zeroes_of<Epi>::value) {
#pragma unroll
        for (int a = 0; a < 2; ++a)
#pragma unroll
            for (int b = 0; b < 2; ++b)
#pragma unroll
                for (int m = 0; m < 4; ++m)
#pragma unroll
                    for (int n = 0; n < 2; ++n) acc[a][b][m][n] = (f32x4){0.f, 0.f, 0.f, 0.f};
        }
        cur = nxt; cA = nA; cB = nB; chA = nhA; csel = nsel; cnt = nnt; ++ui;
        if (wr == 1) PG8_BAR;
    }
    PG8_WAIT_V(0);
    PG8_BAR;
#undef GB_NEXT
#undef GB_OPS
#undef GB_VA
#undef GB_STAGE_A
#undef PG8_SA
#undef PG8_SB
#undef PG8_STAGE
#undef PG8_LDA
#undef PG8_LDB
#undef PG8_MMA
#undef PG8_WAIT_V
#undef PG8_WAIT_L
#undef PG8_BAR
#undef PG8_SCHED
}
}
namespace pg8 {
#define EPI_LOOP_AM _Pragma("unroll") for (int ai = 0; ai < 2; ++ai) _Pragma("unroll") for (int m = 0; m < 4; ++m)
#define EPI_CLR(a0, a1) do { f32x4 z0_ = (f32x4){0.f, 0.f, 0.f, 0.f}, z1_ = (f32x4){0.f, 0.f, 0.f, 0.f}; asm volatile("" : "+v"(z0_), "+v"(z1_) :: "memory"); a0 = z0_; a1 = z1_; __builtin_amdgcn_sched_barrier(0); } while (0)

struct EpiProj {
    bf16_t* O; int ldc; float qs;
    static constexpr bool ZEROES = true;
    __device__ __forceinline__ void operator()(f32x4 (&acc)[2][2][4][2], const Unit& u, int wr, int wc, int fr, int fq) const {
        const int pn = u.pn; const bool act = (pn < 4) || (pn == 6) || (pn == 7); const float sc = (pn == 8 || pn == 9 || pn == 11 || pn == 12) ? qs : 1.f;
        const int row0 = u.pm * BM + wr * 64 + fr, col0 = pn * BM + wc * 32 + 8 * fq;
        EPI_LOOP_AM { bf16_t* rowp = O + (size_t)(row0 + ai * HALF + m * 16) * ldc + col0;
#pragma unroll
            for (int bj = 0; bj < 2; ++bj) { f32x4 v0 = acc[ai][bj][m][0], v1 = acc[ai][bj][m][1];
                if (act) {
#pragma unroll
                    for (int j = 0; j < 4; ++j) { v0[j] = gelu_tanh(v0[j]); v1[j] = gelu_tanh(v1[j]); } }
                v0 = v0 * sc; v1 = v1 * sc; *(u32x4*)(rowp + bj * HALF) = pack8(v0, v1); EPI_CLR(acc[ai][bj][m][0], acc[ai][bj][m][1]); } }
    }
};
__device__ __forceinline__ float rstd_from_ssq(const float* ssq, int row) { const f32x4* p = (const f32x4*)(ssq + (size_t)row * 16); const f32x4 a = p[0], b = p[1], c = p[2], d = p[3];
    const float s = ((a[0] + a[1]) + (a[2] + a[3])) + ((b[0] + b[1]) + (b[2] + b[3])) + ((c[0] + c[1]) + (c[2] + c[3])) + ((d[0] + d[1]) + (d[2] + d[3])); return 1.0f / sqrtf(s * (1.0f / 1024.0f) + 1e-6f); }
struct EpiBf16Rs {
    bf16_t* O; int ldc; const float* ssq;
    static constexpr bool ZEROES = true;
    __device__ __forceinline__ void operator()(f32x4 (&acc)[2][2][4][2], const Unit& u, int wr, int wc, int fr, int fq) const {
        const int row0 = u.pm * BM + wr * 64 + fr, col0 = u.pn * BM + wc * 32 + 8 * fq;
        EPI_LOOP_AM { const int row = row0 + ai * HALF + m * 16; bf16_t* rowp = O + (size_t)row * ldc + col0; const float r_ = rstd_from_ssq(ssq, row);
#pragma unroll
            for (int bj = 0; bj < 2; ++bj) { *(u32x4*)(rowp + bj * HALF) = pack8(acc[ai][bj][m][0] * r_, acc[ai][bj][m][1] * r_); EPI_CLR(acc[ai][bj][m][0], acc[ai][bj][m][1]); } }
    }
};
struct EpiBf16 {
    bf16_t* O; int ldc;
    static constexpr bool ZEROES = true;
    __device__ __forceinline__ void operator()(f32x4 (&acc)[2][2][4][2], const Unit& u, int wr, int wc, int fr, int fq) const {
        const int row0 = u.pm * BM + wr * 64 + fr, col0 = u.pn * BM + wc * 32 + 8 * fq;
        EPI_LOOP_AM { bf16_t* rowp = O + (size_t)(row0 + ai * HALF + m * 16) * ldc + col0;
#pragma unroll
            for (int bj = 0; bj < 2; ++bj) { *(u32x4*)(rowp + bj * HALF) = pack8(acc[ai][bj][m][0], acc[ai][bj][m][1]); EPI_CLR(acc[ai][bj][m][0], acc[ai][bj][m][1]); } }
    }
};
struct EpiGate {
    bf16_t* O; int ldc; const float* bias;
    __device__ __forceinline__ void operator()(const f32x4 (&acc)[2][2][4][2], const Unit& u, int wr, int wc, int fr, int fq) const {
        const int row0 = u.pm * BM + wr * 64 + fr, col0 = u.pn * BM + wc * 32 + 8 * fq;
        f32x4 bv[2][2];
#pragma unroll
        for (int bj = 0; bj < 2; ++bj)
#pragma unroll
            for (int n = 0; n < 2; ++n) bv[bj][n] = *(const f32x4*)(bias + col0 + bj * HALF + 4 * n);
        EPI_LOOP_AM { bf16_t* rowp = O + (size_t)(row0 + ai * HALF + m * 16) * ldc + col0;
#pragma unroll
            for (int bj = 0; bj < 2; ++bj) { f32x4 v0 = acc[ai][bj][m][0] + bv[bj][0], v1 = acc[ai][bj][m][1] + bv[bj][1];
#pragma unroll
                for (int j = 0; j < 4; ++j) { v0[j] = fast_sigmoid(v0[j]); v1[j] = fast_sigmoid(v1[j]); }
                *(u32x4*)(rowp + bj * HALF) = pack8(v0, v1); } }
    }
};
struct EpiBiasRaw {
    bf16_t* O; int ldc; const float* bias;
    __device__ __forceinline__ void operator()(const f32x4 (&acc)[2][2][4][2], const Unit& u, int wr, int wc, int fr, int fq) const {
        const int row0 = u.pm * BM + wr * 64 + fr, col0 = u.pn * BM + wc * 32 + 8 * fq;
        f32x4 bv[2][2];
#pragma unroll
        for (int bj = 0; bj < 2; ++bj)
#pragma unroll
            for (int n = 0; n < 2; ++n) bv[bj][n] = *(const f32x4*)(bias + col0 + bj * HALF + 4 * n);
        EPI_LOOP_AM { bf16_t* rowp = O + (size_t)(row0 + ai * HALF + m * 16) * ldc + col0;
#pragma unroll
            for (int bj = 0; bj < 2; ++bj) { f32x4 v0 = acc[ai][bj][m][0] + bv[bj][0], v1 = acc[ai][bj][m][1] + bv[bj][1];
                *(u32x4*)(rowp + bj * HALF) = pack8(v0, v1); } }
    }
};
struct EpiBranch {
    const bf16_t* G; bf16_t* Mg; int ldc; int first;
    __device__ __forceinline__ void operator()(const f32x4 (&acc)[2][2][4][2], const Unit& u, int wr, int wc, int fr, int fq) const {
        const int row0 = u.pm * BM + wr * 64 + fr, col0 = u.pn * BM + wc * 32 + 8 * fq;
        EPI_LOOP_AM { const size_t off = (size_t)(row0 + ai * HALF + m * 16) * ldc + col0;
#pragma unroll
            for (int bj = 0; bj < 2; ++bj) { const u32x4 g = *(const u32x4*)(G + off + bj * HALF); u32x4 mo = (u32x4){0u, 0u, 0u, 0u}; if (!first) mo = *(const u32x4*)(Mg + off + bj * HALF);
                const f32x4 a0 = acc[ai][bj][m][0], a1 = acc[ai][bj][m][1]; f32x4 v0, v1;
                v0[0] = bf_lo(mo.x) + bf_lo(g.x) * a0[0]; v0[1] = bf_hi(mo.x) + bf_hi(g.x) * a0[1]; v0[2] = bf_lo(mo.y) + bf_lo(g.y) * a0[2]; v0[3] = bf_hi(mo.y) + bf_hi(g.y) * a0[3];
                v1[0] = bf_lo(mo.z) + bf_lo(g.z) * a1[0]; v1[1] = bf_hi(mo.z) + bf_hi(g.z) * a1[1]; v1[2] = bf_lo(mo.w) + bf_lo(g.w) * a1[2]; v1[3] = bf_hi(mo.w) + bf_hi(g.w) * a1[3];
                *(u32x4*)(Mg + off + bj * HALF) = pack8(v0, v1); } }
    }
};
template <int VAR = 0> struct EpiGateBranch {
    bf16_t* G; bf16_t* Mg; int ldc; const float* bias;
    __device__ __forceinline__ void operator()(const f32x4 (&acc)[2][2][4][2], const GBUnit& u, int wr, int wc, int fr, int fq) const {
        const int row0 = u.pm * BM + wr * 64 + fr, col0 = u.pn * BM + wc * 32 + 8 * fq; const int br = u.sub >> 1;
        if ((u.sub & 1) == 0) {
            f32x4 bv[2][2];
#pragma unroll
            for (int bj = 0; bj < 2; ++bj)
#pragma unroll
                for (int n = 0; n < 2; ++n) bv[bj][n] = *(const f32x4*)(bias + br * 1024 + col0 + bj * HALF + 4 * n);
            EPI_LOOP_AM { bf16_t* rowp = G + (size_t)(row0 + ai * HALF + m * 16) * ldc + col0;
#pragma unroll
                for (int bj = 0; bj < 2; ++bj) { f32x4 v0 = acc[ai][bj][m][0] + bv[bj][0], v1 = acc[ai][bj][m][1] + bv[bj][1];
#pragma unroll
                    for (int j = 0; j < 4; ++j) { if (!(VAR & 1)) { v0[j] = fast_sigmoid(v0[j]); v1[j] = fast_sigmoid(v1[j]); } }
                    if (VAR < 4 || v0[0] == 12345.f) *(u32x4*)(rowp + bj * HALF) = pack8(v0, v1); } }
        } else {
            EPI_LOOP_AM { const size_t off = (size_t)(row0 + ai * HALF + m * 16) * ldc + col0;
#pragma unroll
                for (int bj = 0; bj < 2; ++bj) { u32x4 g = (u32x4){0x3f803f80u, 0x3f803f80u, 0x3f803f80u, 0x3f803f80u}; if (!(VAR & 2)) g = __builtin_nontemporal_load((const u32x4*)(G + off + bj * HALF)); u32x4 mo = (u32x4){0u, 0u, 0u, 0u}; if (br != 0 && !(VAR & 2)) mo = __builtin_nontemporal_load((const u32x4*)(Mg + off + bj * HALF));
                    const f32x4 a0 = acc[ai][bj][m][0], a1 = acc[ai][bj][m][1]; f32x4 v0, v1;
                    v0[0] = bf_lo(mo.x) + bf_lo(g.x) * a0[0]; v0[1] = bf_hi(mo.x) + bf_hi(g.x) * a0[1]; v0[2] = bf_lo(mo.y) + bf_lo(g.y) * a0[2]; v0[3] = bf_hi(mo.y) + bf_hi(g.y) * a0[3];
                    v1[0] = bf_lo(mo.z) + bf_lo(g.z) * a1[0]; v1[1] = bf_hi(mo.z) + bf_hi(g.z) * a1[1]; v1[2] = bf_lo(mo.w) + bf_lo(g.w) * a1[2]; v1[3] = bf_hi(mo.w) + bf_hi(g.w) * a1[3];
                    if (VAR < 4 || v0[0] == 12345.f) *(u32x4*)(Mg + off + bj * HALF) = pack8(v0, v1); } }
        }
    }
};
template <bool BASE_F32, bool SSQ_OUT = false> struct EpiResid {
    const float* X; bf16_t* H; int ldc; float* ssq;
    static constexpr bool ZEROES = true;
    __device__ __forceinline__ void operator()(f32x4 (&acc)[2][2][4][2], const Unit& u, int wr, int wc, int fr, int fq) const {
        const int row0 = u.pm * BM + wr * 64 + fr, col0 = u.pn * BM + wc * 32 + 8 * fq;
        EPI_LOOP_AM { const size_t off = (size_t)(row0 + ai * HALF + m * 16) * ldc + col0; float sq = 0.f;
#pragma unroll
            for (int bj = 0; bj < 2; ++bj) { f32x4 h0, h1;
                if (BASE_F32) { h0 = *(const f32x4*)(X + off + bj * HALF); h1 = *(const f32x4*)(X + off + bj * HALF + 4); }
                else { const u32x4 w = *(const u32x4*)(H + off + bj * HALF); h0 = (f32x4){bf_lo(w.x), bf_hi(w.x), bf_lo(w.y), bf_hi(w.y)}; h1 = (f32x4){bf_lo(w.z), bf_hi(w.z), bf_lo(w.w), bf_hi(w.w)}; }
                const u32x4 pk = pack8(h0 + acc[ai][bj][m][0], h1 + acc[ai][bj][m][1]); *(u32x4*)(H + off + bj * HALF) = pk; EPI_CLR(acc[ai][bj][m][0], acc[ai][bj][m][1]);
                if (SSQ_OUT) { const float e0 = bf_lo(pk.x), e1 = bf_hi(pk.x), e2 = bf_lo(pk.y), e3 = bf_hi(pk.y), e4 = bf_lo(pk.z), e5 = bf_hi(pk.z), e6 = bf_lo(pk.w), e7 = bf_hi(pk.w); sq += ((e0 * e0 + e1 * e1) + (e2 * e2 + e3 * e3)) + ((e4 * e4 + e5 * e5) + (e6 * e6 + e7 * e7)); } }
            if (SSQ_OUT) { sq += __shfl_xor(sq, 16); sq += __shfl_xor(sq, 32); if (fq == 0) ssq[(size_t)(row0 + ai * HALF + m * 16) * 16 + u.pn * 4 + wc] = sq; } }
    }
};
template <bool RS = false> struct EpiSwiglu {
    bf16_t* O; int ldc; const float* ssq;
    unsigned* waitc = nullptr; int nwait = 0; unsigned* tmo = nullptr;
    static constexpr bool ZEROES = true;
    __device__ __forceinline__ void operator()(f32x4 (&acc)[2][2][4][2], const Unit& u, int wr, int wc, int fr, int fq) const {
        if (waitc != nullptr && u.pm < nwait) {
            if (fr == 0 && fq == 0) { unsigned sp_ = 0u;
                while (__hip_atomic_load(waitc + u.pm, __ATOMIC_RELAXED, __HIP_MEMORY_SCOPE_AGENT) < 4u) { __builtin_amdgcn_s_sleep(2); if (++sp_ > (1u << 22)) { atomicAdd(tmo, 1u); break; } } }
            asm volatile("" ::: "memory"); }
        const int row0 = u.pm * BM + wr * 64 + fr, col0 = u.pn * HALF + wc * 32 + 8 * fq;
        EPI_LOOP_AM { const int row = row0 + ai * HALF + m * 16; bf16_t* rowp = O + (size_t)row * ldc + col0; f32x4 v0, v1; float r_ = 1.0f;
            if (RS) { const f32x4 q = *(const f32x4*)(ssq + (size_t)row * 16 + 4 * fq); float s = (q[0] + q[1]) + (q[2] + q[3]); s += __shfl_xor(s, 16); s += __shfl_xor(s, 32); r_ = 1.0f / sqrtf(s * (1.0f / 1024.0f) + 1e-6f); }
#pragma unroll
            for (int j = 0; j < 4; ++j) { const float g0 = acc[ai][0][m][0][j] * r_, g1 = acc[ai][0][m][1][j] * r_; v0[j] = g0 * fast_sigmoid(g0) * (acc[ai][1][m][0][j] * r_); v1[j] = g1 * fast_sigmoid(g1) * (acc[ai][1][m][1][j] * r_); }
            *(u32x4*)rowp = pack8(v0, v1); EPI_CLR(acc[ai][0][m][0], acc[ai][0][m][1]); EPI_CLR(acc[ai][1][m][0], acc[ai][1][m][1]); }
    }
};
struct EpiLru {
    const bf16_t* XC; bf16_t* OM; bf16_t* INP; int ldo; const float* ba; const float* bx; const float* lam;
    __device__ __forceinline__ void operator()(const f32x4 (&acc)[2][2][4][2], const Unit& u, int wr, int wc, int fr, int fq) const {
        const int row0 = u.pm * BM + wr * 64 + fr, ch0 = u.pn * HALF + wc * 32 + 8 * fq;
        float bav[8], bxv[8], sp[8];
#pragma unroll
        for (int j = 0; j < 8; ++j) { bav[j] = ba[ch0 + j]; bxv[j] = bx[ch0 + j]; sp[j] = -8.0f * 1.4426950408889634f * log1pf(__expf(-lam[ch0 + j])); }
        EPI_LOOP_AM { const int row = row0 + ai * HALF + m * 16; const u32x4 xw = *(const u32x4*)(XC + (size_t)row * 512 + ch0);
            const float xv[8] = {bf_lo(xw.x), bf_hi(xw.x), bf_lo(xw.y), bf_hi(xw.y), bf_lo(xw.z), bf_hi(xw.z), bf_lo(xw.w), bf_hi(xw.w)};
            f32x4 o0, o1, p0, p1;
#pragma unroll
            for (int j = 0; j < 8; ++j) { const float rp = (j < 4 ? acc[ai][0][m][0][j] : acc[ai][0][m][1][j - 4]) + bav[j], ip = (j < 4 ? acc[ai][1][m][0][j] : acc[ai][1][m][1][j - 4]) + bxv[j];
                const float r = fast_sigmoid(rp), ig = fast_sigmoid(ip); const float a = __builtin_amdgcn_exp2f(r * sp[j]); const float om = 1.0f - a; const float mult = __builtin_sqrtf(om * (1.0f + a));
                const float in = xv[j] * ig * mult; if (j < 4) { o0[j] = om; p0[j] = in; } else { o1[j - 4] = om; p1[j - 4] = in; } }
            *(u32x4*)(OM + (size_t)row * ldo + ch0) = pack8(o0, o1); *(u32x4*)(INP + (size_t)row * ldo + ch0) = pack8(p0, p1); }
    }
};
struct EpiMoeOut {
    bf16_t* H; const int* s2t; const float* sw; unsigned* done = nullptr;
    static constexpr bool ZEROES = true;
    __device__ __forceinline__ void operator()(f32x4 (&acc)[2][2][4][2], const Unit& u, int wr, int wc, int fr, int fq) const {
        const int row0 = u.pm * BM + wr * 64 + fr, col0 = u.pn * BM + wc * 32 + 8 * fq;
        EPI_LOOP_AM { const int slot = row0 + ai * HALF + m * 16; const int tok = s2t[slot]; const float w = sw[slot];
            if (tok >= 0) { bf16_t* rowp = H + (size_t)tok * 1024 + col0;
#pragma unroll
                for (int bj = 0; bj < 2; ++bj) { const u32x4 x = *(const u32x4*)(rowp + bj * HALF); const f32x4 h0 = (f32x4){bf_lo(x.x), bf_hi(x.x), bf_lo(x.y), bf_hi(x.y)}, h1 = (f32x4){bf_lo(x.z), bf_hi(x.z), bf_lo(x.w), bf_hi(x.w)};
                    *(u32x4*)(rowp + bj * HALF) = pack8(h0 + acc[ai][bj][m][0] * w, h1 + acc[ai][bj][m][1] * w); } }
            EPI_CLR(acc[ai][0][m][0], acc[ai][0][m][1]); EPI_CLR(acc[ai][1][m][0], acc[ai][1][m][1]); }
        if (done != nullptr && wr == 0 && wc == 0 && fr == 0 && fq == 0) (void)__hip_atomic_fetch_add(done + u.pm, 1u, __ATOMIC_RELAXED, __HIP_MEMORY_SCOPE_AGENT);
    }
};
struct EpiSoftmax {
    bf16_t* P; int ldc; PG8_LAS float* xch;
    __device__ __forceinline__ void operator()(f32x4 (&acc)[2][2][4][2], const Unit& u, int wr, int wc, int fr, int fq) const {
        const int row0 = u.pm * BM + wr * 64 + fr, col0 = u.pn * BM + wc * 32 + 8 * fq;
        EPI_LOOP_AM { float mx = -INFINITY;
#pragma unroll
            for (int bj = 0; bj < 2; ++bj)
#pragma unroll
                for (int n = 0; n < 2; ++n)
#pragma unroll
                    for (int j = 0; j < 4; ++j) mx = fmaxf(mx, acc[ai][bj][m][n][j]);
            mx = fmaxf(mx, __shfl_xor(mx, 16)); mx = fmaxf(mx, __shfl_xor(mx, 32));
            if (fq == 0) xch[(ai * HALF + wr * 64 + m * 16 + fr) * 4 + wc] = mx; }
        asm volatile("s_waitcnt lgkmcnt(0)" ::: "memory"); __builtin_amdgcn_s_barrier(); asm volatile("" ::: "memory");
        EPI_LOOP_AM { const int r = ai * HALF + wr * 64 + m * 16 + fr; const f32x4 q = *(const PG8_LAS f32x4*)(xch + r * 4); const float mx = fmaxf(fmaxf(q[0], q[1]), fmaxf(q[2], q[3])); float s = 0.f;
#pragma unroll
            for (int bj = 0; bj < 2; ++bj)
#pragma unroll
                for (int n = 0; n < 2; ++n)
#pragma unroll
                    for (int j = 0; j < 4; ++j) { const float p = __builtin_amdgcn_exp2f(acc[ai][bj][m][n][j] - mx); acc[ai][bj][m][n][j] = p; s += p; }
            s += __shfl_xor(s, 16); s += __shfl_xor(s, 32);
            if (fq == 0) xch[1024 + r * 4 + wc] = s; }
        asm volatile("s_waitcnt lgkmcnt(0)" ::: "memory"); __builtin_amdgcn_s_barrier(); asm volatile("" ::: "memory");
        EPI_LOOP_AM { const int r = ai * HALF + wr * 64 + m * 16 + fr; const f32x4 q = *(const PG8_LAS f32x4*)(xch + 1024 + r * 4); const float inv = __builtin_amdgcn_rcpf((q[0] + q[1]) + (q[2] + q[3]));
            bf16_t* rowp = P + (size_t)(row0 + ai * HALF + m * 16) * ldc + col0;
#pragma unroll
            for (int bj = 0; bj < 2; ++bj) *(u32x4*)(rowp + bj * HALF) = pack8(acc[ai][bj][m][0] * inv, acc[ai][bj][m][1] * inv); }
    }
};
#undef EPI_LOOP_AM
#undef EPI_CLR
}
#include <hip/hip_bf16.h>
#include <cmath>
namespace attn_body {
using bf16=__hip_bfloat16;
using bf16x8=__attribute__((ext_vector_type(8)))short;
using s16x4=__attribute__((ext_vector_type(4)))short;
using f32x16=__attribute__((ext_vector_type(16)))float;
using u32x4=__attribute__((ext_vector_type(4)))unsigned;
using f32x4=__attribute__((ext_vector_type(4)))float;
constexpr int SEQ=8192,D=64,DM=4352;
constexpr int NW=8,QBLK=32,QB=QBLK*NW,KVBLK=64,NQB=SEQ/QB;
__device__ __forceinline__ int crow(int r,int hi){return (r&3)+8*(r>>2)+4*hi;}
#define SBAR() __builtin_amdgcn_sched_barrier(0)
__device__ __forceinline__ void cmask(f32x16&p0,f32x16&p1,int jb,int qrel,int hi){
  const float NEG=-INFINITY; int kb=64*jb+4*hi;
  #pragma unroll
  for(int r=0;r<16;++r){int kv=kb+(r&3)+8*(r>>2); if(kv>qrel)p0[r]=NEG; if(kv+32>qrel)p1[r]=NEG;}
}

__device__ __forceinline__ void wmask(f32x16&p0,f32x16&p1,int v,int qrel,int hi){
  const float NEG=-INFINITY; int kb=64*v+4*hi;
  #pragma unroll
  for(int r=0;r<16;++r){int kv=kb+(r&3)+8*(r>>2); if(kv<=qrel)p0[r]=NEG; if(kv+32<=qrel)p1[r]=NEG;}
}
constexpr int NSLOT=3, SLOTB=8192;
constexpr int LDS_K=0, LDS_V=NSLOT*SLOTB, LDS_WS=2*NSLOT*SLOTB, LDS_OST=LDS_WS+NW*64*4, LDS_BYTES=LDS_OST+NW*4096;
constexpr float C2=0.125f*1.4426950408889634f;
__device__ __forceinline__ void glds16(const void*gsrc,unsigned lds_dst){unsigned keep;
  asm volatile("s_mov_b32 %0, m0\n\ts_mov_b32 m0, %2\n\ts_nop 0\n\tglobal_load_lds_dwordx4 %1, off\n\ts_mov_b32 m0, %0":"=&s"(keep):"v"(gsrc),"s"(lds_dst):"memory");}
__device__ __forceinline__ float max3f(float a,float b,float c){float r;asm("v_max3_f32 %0, %1, %2, %3":"=v"(r):"v"(a),"v"(b),"v"(c));return r;}
__device__ __forceinline__ float max2f(float a,float b){float r;asm("v_max_f32_e32 %0, %1, %2":"=v"(r):"v"(a),"v"(b));return r;}
__device__ __forceinline__ float fadd_s(float a,float b){float r;asm("v_add_f32_e32 %0, %1, %2":"=v"(r):"v"(a),"v"(b));return r;}
__device__ __forceinline__ float fsub_s(float a,float b){float r;asm("v_sub_f32_e32 %0, %1, %2":"=v"(r):"v"(a),"v"(b));return r;}
typedef float f32x2_t __attribute__((ext_vector_type(2))); typedef __bf16 bf16x2_t __attribute__((ext_vector_type(2)));
__device__ __forceinline__ unsigned cvtpk_s(float lo,float hi){f32x2_t v={lo,hi};bf16x2_t b=__builtin_convertvector(v,bf16x2_t);return __builtin_bit_cast(unsigned,b);}
#define WAIT_BAR(N) asm volatile("s_waitcnt vmcnt(" #N ") lgkmcnt(0)\n\ts_barrier":::"memory")

__device__ __forceinline__ void qkt(f32x16&p0,f32x16&p1,const char*Kslot,const bf16x8*qr,int r32,int hi){
  const char*kb=Kslot+hi*1024+r32*16;
  #pragma unroll
  for(int d0=0;d0<4;++d0){
    const bf16x8 b0=*reinterpret_cast<const bf16x8*>(kb+d0*2048);
    const bf16x8 b1=*reinterpret_cast<const bf16x8*>(kb+d0*2048+512);
    p0=__builtin_amdgcn_mfma_f32_32x32x16_bf16(b0,qr[d0],p0,0,0,0);p1=__builtin_amdgcn_mfma_f32_32x32x16_bf16(b1,qr[d0],p1,0,0,0);}
}
typedef __attribute__((address_space(3))) const char* lds_cptr;
typedef short v4i16_t __attribute__((ext_vector_type(4)));
__device__ __forceinline__ void kload8(bf16x8*kf,lds_cptr kp){
  kf[0]=*(const __attribute__((address_space(3))) bf16x8*)(kp);      kf[1]=*(const __attribute__((address_space(3))) bf16x8*)(kp+512);
  kf[2]=*(const __attribute__((address_space(3))) bf16x8*)(kp+2048); kf[3]=*(const __attribute__((address_space(3))) bf16x8*)(kp+2560);
  kf[4]=*(const __attribute__((address_space(3))) bf16x8*)(kp+4096); kf[5]=*(const __attribute__((address_space(3))) bf16x8*)(kp+4608);
  kf[6]=*(const __attribute__((address_space(3))) bf16x8*)(kp+6144); kf[7]=*(const __attribute__((address_space(3))) bf16x8*)(kp+6656);
}
__device__ __forceinline__ void kload2(bf16x8*kf,lds_cptr kp,int j){ kf[2*j]=*(const __attribute__((address_space(3))) bf16x8*)(kp+j*2048); kf[2*j+1]=*(const __attribute__((address_space(3))) bf16x8*)(kp+j*2048+512); }
__device__ __forceinline__ s16x4 vtr(lds_cptr p){ return __builtin_bit_cast(s16x4,__builtin_amdgcn_ds_read_tr16_b64_v4i16((__attribute__((address_space(3))) v4i16_t*)p)); }
__device__ __forceinline__ float rowmax(const f32x16&p0,const f32x16&p1){
  float a=max3f(p0[0],p0[1],p1[0]),b=max3f(p0[2],p0[3],p1[1]);a=max3f(a,p1[2],p1[3]);
  #pragma unroll
  for(int r=4;r<16;r+=4){a=max3f(a,p0[r],p0[r+1]);b=max3f(b,p0[r+2],p0[r+3]);a=max3f(a,p1[r],p1[r+1]);b=max3f(b,p1[r+2],p1[r+3]);}
  const float m=max2f(a,b);
  auto rr=__builtin_amdgcn_permlane32_swap(__float_as_uint(m),__float_as_uint(m),false,false);
  return max2f(__uint_as_float(rr[0]),__uint_as_float(rr[1]));
}
__device__ __forceinline__ void pv(f32x16*o,int vb,bf16x8 pa0,bf16x8 pa1,bf16x8 pa2,bf16x8 pa3){
  #pragma unroll
  for(int d0=0;d0<2;++d0){s16x4 lo[4],hi[4];
    #pragma unroll
    for(int ks=0;ks<4;++ks){
      asm volatile("ds_read_b64_tr_b16 %0,%1 offset:%c2":"=&v"(lo[ks]):"v"(vb),"i"(d0*4096+ks*1024):"memory");
      asm volatile("ds_read_b64_tr_b16 %0,%1 offset:%c2":"=&v"(hi[ks]):"v"(vb),"i"(d0*4096+ks*1024+512):"memory");}
    asm volatile("s_waitcnt lgkmcnt(0)":::"memory");SBAR();
    #define PK(k) (bf16x8){lo[k][0],lo[k][1],lo[k][2],lo[k][3],hi[k][0],hi[k][1],hi[k][2],hi[k][3]}
    o[d0]=__builtin_amdgcn_mfma_f32_32x32x16_bf16(pa0,PK(0),o[d0],0,0,0);
    o[d0]=__builtin_amdgcn_mfma_f32_32x32x16_bf16(pa1,PK(1),o[d0],0,0,0);
    o[d0]=__builtin_amdgcn_mfma_f32_32x32x16_bf16(pa2,PK(2),o[d0],0,0,0);
    o[d0]=__builtin_amdgcn_mfma_f32_32x32x16_bf16(pa3,PK(3),o[d0],0,0,0);
    #undef PK
  }
}

#ifndef ATTN_STORE16
#define ATTN_STORE16(p,v) (*(u32x4*)(p)=(v))
#endif
template<int THRL,int MODE> __device__ __forceinline__ void attn_unit(const bf16*Qw0,const bf16*__restrict__ Kh,const bf16*__restrict__ Vh,bf16*Ow0,const int NT,const int voff,const __attribute__((address_space(3))) float*ckrel,const int cqidx,const float sink2,const float slope2,char*shm){
  int tid_=threadIdx.x; asm volatile("":"+v"(tid_));
  const int tid=tid_,lane=tid&63,r32=lane&31,hi=lane>>5; const int wid=__builtin_amdgcn_readfirstlane(tid>>6);
  const bf16*Qw=Qw0+(long)(wid*QBLK)*DM;
  const unsigned lds0=(unsigned)(uintptr_t)shm;
  float*wsf=(float*)(shm+LDS_WS)+wid*64;
  const bf16*ksrc=Kh+(long)lane*DM+wid*8;
  const bf16*vsrc=Vh+(long)(16*(wid&3)+(lane>>2))*DM+(wid>>2)*32+(lane&3)*8;
  const unsigned kdst=lds0+LDS_K+wid*1024, vdst=lds0+LDS_V+wid*1024;
  #define DMA_K(t,slot) glds16(ksrc+(long)(t)*KVBLK*DM,(unsigned)__builtin_amdgcn_readfirstlane(kdst+(slot)))
  #define DMA_V(t,slot) glds16(vsrc+(long)(t)*KVBLK*DM,(unsigned)__builtin_amdgcn_readfirstlane(vdst+(slot)))
  const int vb0=(int)(lds0+LDS_V)+((lane>>4)&1)*32+(lane&3)*8+(4*hi+((lane&15)>>2))*64;
  const char*Kbase=shm+LDS_K; bf16x8 kf[8];
  const lds_cptr shm3=(lds_cptr)shm; const lds_cptr kp0=shm3+LDS_K+hi*1024+r32*16; const lds_cptr vp0=shm3+LDS_V+((lane>>4)&1)*32+(lane&3)*8+(4*hi+((lane&15)>>2))*64;
  DMA_K(0,0);DMA_V(0,0);DMA_K(1,SLOTB);
  bf16x8 qr[4];
  #pragma unroll
  for(int d0=0;d0<4;++d0)qr[d0]=*reinterpret_cast<const bf16x8*>(&Qw[(long)r32*DM+d0*16+hi*8]);
  const float cqv=(MODE==1)?(-slope2*(float)(128+wid*QBLK+r32)):ckrel[cqidx+wid*QBLK+r32];
  float mhat=-cqv,l_reg=0.f;     f32x16 o[2];o[0]=f32x16{};o[1]=f32x16{};
  const int qrel=wid*QBLK+r32;
  #define CMASK(P0,P1,t) do{int jb_=(t)-(NT-4); if(jb_>=0)cmask(P0,P1,jb_,qrel,hi); if(MODE==1){int v_=(t)+voff; if(v_<4)wmask(P0,P1,v_,qrel,hi);} }while(0)
  #define CINIT(P0,P1,t) do{ const __attribute__((address_space(3))) float*cp_=ckrel+(t)*64+4*hi; const float nm_=-mhat; \
    _Pragma("unroll") for(int rr_=0;rr_<4;++rr_){ const f32x4 a_=*(const __attribute__((address_space(3))) f32x4*)(cp_+8*rr_); const f32x4 b_=*(const __attribute__((address_space(3))) f32x4*)(cp_+32+8*rr_); \
      _Pragma("unroll") for(int j_=0;j_<4;++j_){P0[4*rr_+j_]=nm_-a_[j_];P1[4*rr_+j_]=nm_-b_[j_];} } }while(0)
  bool resc=false;
  #define START(P0,P1) do{ const float rm=rowmax(P0,P1); resc=false; \
    { const float dl=__builtin_fmaxf(rm,0.f);     mhat=fadd_s(mhat,dl); \
      _Pragma("unroll") for(int r=0;r<16;++r){P0[r]=fsub_s(P0[r],dl);P1[r]=fsub_s(P1[r],dl);} } \
    _Pragma("unroll") for(int r=0;r<16;++r)P0[r]=__builtin_amdgcn_exp2f(P0[r]); }while(0)
  #define RESC() do{ if(resc){ asm volatile("s_waitcnt lgkmcnt(0)":::"memory"); \
      _Pragma("unroll") for(int d_=0;d_<2;++d_) _Pragma("unroll") for(int r=0;r<16;++r)o[d_][r]*=wsf[crow(r,hi)]; } }while(0)
  f32x16 pA0,pA1,pB0,pB1;
  int sl_prev=0,sl_cur=0,sl_next=SLOTB;
  #define ROT() do{sl_prev=sl_cur;sl_cur=sl_next;sl_next=(sl_next==(NSLOT-1)*SLOTB)?0:sl_next+SLOTB;}while(0)
  DMA_K(2,2*SLOTB);
  WAIT_BAR(3);
  CINIT(pA0,pA1,0);qkt(pA0,pA1,Kbase,qr,r32,hi);asm volatile("s_nop 15\n\ts_nop 7":"+v"(pA0),"+v"(pA1));CMASK(pA0,pA1,0);
  START(pA0,pA1);
  _Pragma("unroll") for(int r=0;r<16;++r)pA1[r]=__builtin_amdgcn_exp2f(pA1[r]);
  WAIT_BAR(0);
  DMA_K(3,0);DMA_V(1,SLOTB);
  ROT();
  kload8(kf,kp0+sl_cur);
  WAIT_BAR(2);
  s16x4 vlo[8],vhi[8]; u32x4 pw0,pw1,pw2,pw3;
  #define PKW(P,B) cvtpk_s(P[B],P[B+1])
  #define PAF(k) __builtin_bit_cast(bf16x8,pw##k)
  #define VFR(i) (bf16x8){vlo[i][0],vlo[i][1],vlo[i][2],vlo[i][3],vhi[i][0],vhi[i][1],vhi[i][2],vhi[i][3]}
  #define PIN(x) asm volatile("":"+v"(x))
  #define MX3(a,b,c) __builtin_fmaxf(__builtin_fmaxf((a),(b)),(c))
  #define GAPA(MF,A0,A1,A2,A3,W0,W1,PW) do{ MF; sacc+=A0; sacc+=A1; sacc+=A2; sacc+=A3; PIN(sacc); W0; W1; PIN(PW); SBAR(); }while(0)
  #define EX(v) __builtin_amdgcn_exp2f(v)
  #define GAPB(MF,X,B) do{ MF; X[B]=EX(X[B]); X[B+1]=EX(X[B+1]); X[B+2]=EX(X[B+2]); X[B+3]=EX(X[B+3]); PIN(X); SBAR(); }while(0)
  #define VRD(i) do{ vlo[i]=vtr(vp_+(((i)>>2)*4096+((i)&3)*1024)); vhi[i]=vtr(vp_+(((i)>>2)*4096+((i)&3)*1024+512)); }while(0)
  #define KRD(G,j) do{ if(G){ kload2(kf,kp0+sl_next,j); SBAR(); } }while(0)
  #define STEP(C0,C1,P0,P1,t,GK,GV,GL) do{ SBAR(); CINIT(C0,C1,t); SBAR(); \
    const lds_cptr vp_=vp0+sl_prev; \
    VRD(0); SBAR(); float sacc=(P0[0]+P0[1]); \
    GAPA(C0=__builtin_amdgcn_mfma_f32_32x32x16_bf16(kf[0],qr[0],C0,0,0,0), P0[2],P0[3],P0[4],P0[5],     pw0[0]=PKW(P0,0), pw0[1]=PKW(P0,2), pw0); \
    VRD(4); SBAR(); GAPA(C1=__builtin_amdgcn_mfma_f32_32x32x16_bf16(kf[1],qr[0],C1,0,0,0), P0[6],P0[7],P0[8],P0[9],     pw0[2]=PKW(P0,4), pw0[3]=PKW(P0,6), pw0); \
    VRD(1); SBAR(); GAPA(C0=__builtin_amdgcn_mfma_f32_32x32x16_bf16(kf[2],qr[1],C0,0,0,0),   P0[10],P0[11],P0[12],P0[13], pw1[0]=PKW(P0,8), pw1[1]=PKW(P0,10), pw1); \
    VRD(5); SBAR(); GAPA(C1=__builtin_amdgcn_mfma_f32_32x32x16_bf16(kf[3],qr[1],C1,0,0,0),   P0[14],P0[15],P1[0],P1[1],   pw1[2]=PKW(P0,12),pw1[3]=PKW(P0,14), pw1); \
    VRD(2); SBAR(); GAPA(C0=__builtin_amdgcn_mfma_f32_32x32x16_bf16(kf[4],qr[2],C0,0,0,0),   P1[2],P1[3],P1[4],P1[5],     pw2[0]=PKW(P1,0), pw2[1]=PKW(P1,2), pw2); \
    VRD(6); SBAR(); GAPA(C1=__builtin_amdgcn_mfma_f32_32x32x16_bf16(kf[5],qr[2],C1,0,0,0),   P1[6],P1[7],P1[8],P1[9],     pw2[2]=PKW(P1,4), pw2[3]=PKW(P1,6), pw2); \
    VRD(3); SBAR(); GAPA(C0=__builtin_amdgcn_mfma_f32_32x32x16_bf16(kf[6],qr[3],C0,0,0,0),   P1[10],P1[11],P1[12],P1[13], pw3[0]=PKW(P1,8), pw3[1]=PKW(P1,10), pw3); \
    VRD(7); SBAR(); GAPA(C1=__builtin_amdgcn_mfma_f32_32x32x16_bf16(kf[7],qr[3],C1,0,0,0),   P1[14],P1[15],0.f,0.f,       pw3[2]=PKW(P1,12),pw3[3]=PKW(P1,14), pw3); \
    l_reg+=sacc; \
    if(GK){DMA_K((t)+3,sl_cur);} if(GV){DMA_V((t)+1,sl_next);} \
    CMASK(C0,C1,t); \
    { float a=MX3(C0[0],C0[1],C1[0]),b=MX3(C0[2],C0[3],C1[1]); a=MX3(a,C1[2],C1[3]); \
      _Pragma("unroll") for(int r=4;r<16;r+=4){a=MX3(a,C0[r],C0[r+1]);b=MX3(b,C0[r+2],C0[r+3]);a=MX3(a,C1[r],C1[r+1]);b=MX3(b,C1[r+2],C1[r+3]);} \
      float rm=__builtin_fmaxf(a,b); { auto rr=__builtin_amdgcn_permlane32_swap(__float_as_uint(rm),__float_as_uint(rm),false,false); rm=__builtin_fmaxf(__uint_as_float(rr[0]),__uint_as_float(rr[1])); } \
      resc=false; \
      if(__builtin_expect(__any(rm>(float)THRL),0)){ const float dl=__builtin_fmaxf(rm,0.f); mhat+=dl; \
        _Pragma("unroll") for(int r=0;r<16;++r){C0[r]-=dl;C1[r]-=dl;} \
        const float f=__builtin_amdgcn_exp2f(-dl); l_reg*=f; if(hi==0)wsf[r32]=f; resc=true; } } \
    SBAR(); \
    GAPB(o[0]=__builtin_amdgcn_mfma_f32_32x32x16_bf16(PAF(0),VFR(0),o[0],0,0,0), C0,0); \
    GAPB(o[1]=__builtin_amdgcn_mfma_f32_32x32x16_bf16(PAF(0),VFR(4),o[1],0,0,0), C0,4); \
    KRD(GL,0); GAPB(o[0]=__builtin_amdgcn_mfma_f32_32x32x16_bf16(PAF(1),VFR(1),o[0],0,0,0), C0,8); \
    KRD(GL,1); GAPB(o[1]=__builtin_amdgcn_mfma_f32_32x32x16_bf16(PAF(1),VFR(5),o[1],0,0,0), C0,12); \
    KRD(GL,2); GAPB(o[0]=__builtin_amdgcn_mfma_f32_32x32x16_bf16(PAF(2),VFR(2),o[0],0,0,0), C1,0); \
    KRD(GL,3); GAPB(o[1]=__builtin_amdgcn_mfma_f32_32x32x16_bf16(PAF(2),VFR(6),o[1],0,0,0), C1,4); \
    GAPB(o[0]=__builtin_amdgcn_mfma_f32_32x32x16_bf16(PAF(3),VFR(3),o[0],0,0,0), C1,8); \
    GAPB(o[1]=__builtin_amdgcn_mfma_f32_32x32x16_bf16(PAF(3),VFR(7),o[1],0,0,0), C1,12); \
    }while(0)
  int t=1;
  #undef CMASK
  #define CMASK(P0,P1,t) do{}while(0)
  for(;t+5<NT;t+=2){
    STEP(pB0,pB1,pA0,pA1,t,true,true,true);     WAIT_BAR(2); RESC(); ROT();
    STEP(pA0,pA1,pB0,pB1,t+1,true,true,true);   WAIT_BAR(2); RESC(); ROT();
  }
  #undef CMASK
  #define CMASK(P0,P1,t) do{int jb_=(t)-(NT-4); if(jb_>=0)cmask(P0,P1,jb_,qrel,hi); if(MODE==1){int v_=(t)+voff; if(v_<4)wmask(P0,P1,v_,qrel,hi);} }while(0)
  #define ENDW(tt) do{ if((tt)+3<NT){WAIT_BAR(2);} else if((tt)+2<NT){WAIT_BAR(1);} else {WAIT_BAR(0);} }while(0)
  for(;t+1<NT;t+=2){
    STEP(pB0,pB1,pA0,pA1,t,(t+3<NT),(t+1<NT),(t+1<NT));       ENDW(t);   RESC(); ROT();
    STEP(pA0,pA1,pB0,pB1,t+1,(t+4<NT),(t+2<NT),(t+2<NT));     ENDW(t+1); RESC(); ROT();
  }
  STEP(pB0,pB1,pA0,pA1,NT-1,false,false,false); RESC();
  { float sacc=pB0[0]+pB0[1]; _Pragma("unroll") for(int r=2;r<16;++r)sacc+=pB0[r]; _Pragma("unroll") for(int r=0;r<16;++r)sacc+=pB1[r]; l_reg+=sacc;
    pw0=(u32x4){PKW(pB0,0),PKW(pB0,2),PKW(pB0,4),PKW(pB0,6)};pw1=(u32x4){PKW(pB0,8),PKW(pB0,10),PKW(pB0,12),PKW(pB0,14)};pw2=(u32x4){PKW(pB1,0),PKW(pB1,2),PKW(pB1,4),PKW(pB1,6)};pw3=(u32x4){PKW(pB1,8),PKW(pB1,10),PKW(pB1,12),PKW(pB1,14)};
    SBAR(); pv(o,vb0+sl_cur,PAF(0),PAF(1),PAF(2),PAF(3)); }
  #undef PKW
  #undef PAF
  #undef VFR
  #undef PIN
  #undef MX3
  #undef GAPA
  #undef GAPB
  #undef EX
  #undef VRD
  #undef KRD
  #undef STEP
  #undef ENDW
  {auto rr=__builtin_amdgcn_permlane32_swap(__float_as_uint(l_reg),__float_as_uint(l_reg),false,false);l_reg=__uint_as_float(rr[0])+__uint_as_float(rr[1]);}
  if(MODE==1)l_reg+=__builtin_amdgcn_exp2f(sink2-mhat+slope2*(float)(128+qrel));
  if(hi==0)wsf[32+r32]=l_reg;asm volatile("s_waitcnt lgkmcnt(0)":::"memory");
  float rli[16];
  #pragma unroll
  for(int r=0;r<16;++r)rli[r]=__builtin_amdgcn_rcpf(wsf[32+crow(r,hi)]);
  bf16*Ow=Ow0+(long)(wid*QBLK)*DM;
  { bf16*stg=(bf16*)(shm+LDS_OST)+wid*2048;
    #pragma unroll
    for(int r=0;r<16;++r){const int orow=crow(r,hi);
      #pragma unroll
      for(int d0=0;d0<2;++d0)stg[orow*64+d0*32+r32]=__float2bfloat16(o[d0][r]*rli[r]);}
    asm volatile("s_waitcnt lgkmcnt(0)":::"memory");
    #pragma unroll
    for(int i=0;i<4;++i){const int row=i*8+(lane>>3),ch=lane&7; const u32x4 v=*(const u32x4*)(stg+row*64+ch*8); ATTN_STORE16(Ow+(long)row*DM+ch*8,v);} }
  asm volatile("s_waitcnt lgkmcnt(0)\n\ts_barrier":::"memory");
  #undef DMA_K
  #undef DMA_V
  #undef CMASK
  #undef CINIT
  #undef START
  #undef RESC
  #undef ROT
}
constexpr int ATTN_LDS_BYTES=LDS_BYTES;
#undef SBAR
#undef WAIT_BAR
}
constexpr int NWAVES = 8;
constexpr int BATCH = 8, SEQ = 8192, DM = 1024, M = BATCH * SEQ, DEPTH = 2, MEMLEN = 256;
constexpr int DIN = 4360, NPROJ = 4352, PP = NPROJ;
constexpr int DFF = 2816, NE = 8;
constexpr float EPS = 1e-6f, LOG2E = 1.4426950408889634f;
constexpr int C_AU = 0, C_AV = 512, C_BX = 1024, C_BY = 1536, C_CQ = 2048, C_CK = 2560, C_CV = 2688, C_DQ = 2816, C_DK = 3328, C_DV = 3840;
constexpr int C_INP = 512, C_OM = 1024;
constexpr int C_G = 512, C_MG = 3328;
constexpr int SLOTS = M + 2048;

constexpr size_t MiB = 1u << 20;
constexpr size_t WS_CTL = 0, CTL_ZERO_BYTES = 160 * 1024;
constexpr size_t WS_LC = 1 * MiB, WS_TOT = 3 * MiB, WS_LA = 4 * MiB, WS_LH = 4 * MiB + 512 * 1024, WS_ROUTE = 5 * MiB, WS_MOE = 6 * MiB;
constexpr size_t WS_MEMN = 8 * MiB, WS_KV = 16 * MiB, WS_WQK = 32 * MiB, WS_VWO = 48 * MiB;
constexpr size_t WS_WIN = 64 * MiB, WS_WG = 81 * MiB, WS_WB = 97 * MiB  , WS_WOUT = 113 * MiB, WS_WQ = 117 * MiB, WS_WKV = 119 * MiB, WS_WOC = 123 * MiB, WS_WLRU = 125 * MiB, WS_WSGU = 127 * MiB;
constexpr size_t WS_W13 = 128 * MiB, WS_W2 = 139 * MiB;
constexpr size_t WS_MW13 = 8 * MiB, WS_MW2 = 96 * MiB;
constexpr size_t WS_H = 145 * MiB;
constexpr size_t WS_XN = 273 * MiB, WS_XC = 401 * MiB, WS_PROJ = 465 * MiB, WS_END = 1009 * MiB;
static_assert(WS_MW2 + (size_t)8 * 1024 * 2816 * 2 <= WS_H && WS_MW13 + (size_t)8 * 5632 * 1024 * 2 <= WS_MW2, "moe weight overlay");
constexpr size_t WS_KN = WS_TOT + 768 * 1024, WS_QN = WS_KN + 64 * 128 * 4, WS_TLO = WS_QN + 64 * 32 * 4;
constexpr size_t WS_CUMT = WS_MOE;
constexpr size_t WS_SSQ = WS_MEMN;
constexpr size_t WS_LA8 = WS_WQK, WS_LH8 = WS_WQK + 4 * MiB;
constexpr size_t WS_XG = WS_PROJ, WS_ACT = WS_PROJ + 132 * MiB;
static_assert(WS_ACT + (size_t)SLOTS * DFF * 2 <= WS_END && (size_t)SLOTS * DM * 2 <= 132 * MiB && WS_PROJ + (size_t)M * PP * 2 <= WS_END, "ws map");
constexpr size_t MOE_S2T = 0, MOE_SW = 2 * (size_t)SLOTS * 4, MOE_TILE_E = 4 * (size_t)SLOTS * 4, MOE_NT = MOE_TILE_E + 2 * 512 * 4, MOE_WGCNT = MOE_NT + 64;
static_assert(MOE_WGCNT + 256 * 16 * 4 <= 2 * MiB, "moe tables");
constexpr int CW_BAR = 4096;
constexpr int CW_MOECNT = 16384;
constexpr int CW_G2DONE = 24576;
constexpr int CW_ATTQ = 20480;

constexpr int RING_OFF = 0, RING_BYTES = 131072;
constexpr int LDSCTL_OFF = 147456 - 1024, MISC_OFF = LDSCTL_OFF + 320;
constexpr int XCH_OFF = RING_BYTES + 4096;
constexpr int LDS_BYTES = 147456;
constexpr int CKL_OFF = 86016;

#define GAS __attribute__((address_space(1)))
#define LAS __attribute__((address_space(3)))
typedef unsigned short bf16;
typedef unsigned v4u __attribute__((ext_vector_type(4)));
typedef unsigned v2u __attribute__((ext_vector_type(2)));
typedef float f32x4 __attribute__((ext_vector_type(4)));
typedef short bf16x8 __attribute__((ext_vector_type(8)));
typedef float f32x16 __attribute__((ext_vector_type(16)));
typedef GAS unsigned gu32;
#define RLX_AGENT __ATOMIC_RELAXED, __HIP_MEMORY_SCOPE_AGENT
#define LDS_WAIT() asm volatile("s_waitcnt lgkmcnt(0)" ::: "memory")
#define VM_WAIT() asm volatile("s_waitcnt vmcnt(0)" ::: "memory")
__device__ __forceinline__ unsigned f2bf(float f) { unsigned u = __builtin_bit_cast(unsigned, f); return (u + 0x7fffu + ((u >> 16) & 1u)) >> 16; }
__device__ __forceinline__ unsigned pk2(float lo, float hi) { return f2bf(lo) | (f2bf(hi) << 16); }
__device__ __forceinline__ float bflo(unsigned w) { return __uint_as_float(w << 16); }
__device__ __forceinline__ float bfhi(unsigned w) { return __uint_as_float(w & 0xffff0000u); }
__device__ __forceinline__ float bf1(bf16 b) { return __uint_as_float(((unsigned)b) << 16); }

#define XB_TMO      128
#define XB_XCNT(j)  (256  + 64 * (j))
#define XB_XSUB(j)  (1280 + 64 * (j))
#define XB_XGEN(j)  (2304 + 64 * (j))
#define XB_TOP      3328
#define XB_TOPGEN   3392
#define XCD_BAR_WORDS 3456
#define XB_SPIN_CAP (1u << 18)
__device__ __forceinline__ unsigned xb_ld(unsigned* p)              { return __hip_atomic_load(p, __ATOMIC_RELAXED, __HIP_MEMORY_SCOPE_AGENT); }
__device__ __forceinline__ unsigned xb_add(unsigned* p, unsigned v) { return __hip_atomic_fetch_add(p, v, __ATOMIC_RELAXED, __HIP_MEMORY_SCOPE_AGENT); }
__device__ __forceinline__ unsigned xb_xcc_id() { return (unsigned)__builtin_amdgcn_s_getreg((3 << 11) | 20) & 0xFu; }
#define XB_SPIN(cond, bar) do { unsigned _sp = 0; while (cond) { __builtin_amdgcn_s_sleep(1); \
    if ((++_sp & 255u) == 0u) { if (xb_ld(&(bar)[XB_TMO])) break; if (_sp > XB_SPIN_CAP) { atomicAdd(&(bar)[XB_TMO], 1u); break; } } } } while (0)
struct XcdBarrier { unsigned* bar; unsigned x; volatile LAS unsigned* st; };
__device__ __forceinline__ XcdBarrier xcd_barrier_post(unsigned* bar, volatile LAS unsigned* st) {
    XcdBarrier b; b.bar = bar; b.x = xb_xcc_id(); b.st = st;
    if (threadIdx.x == 0) (void)xb_add(&bar[XB_XCNT(b.x)], 1u);
    return b;
}
__device__ __forceinline__ void xcd_barrier_complete(unsigned* bar, unsigned x, unsigned& nloc, unsigned& nx) {
    const unsigned G = gridDim.x * gridDim.y * gridDim.z;
    unsigned sum, cnt, mine, sp = 0u;
    for (;;) {
        sum = 0u; cnt = 0u; mine = 0u;
#pragma unroll
        for (unsigned j = 0; j < 16; ++j) { const unsigned c = xb_ld(&bar[XB_XCNT(j)]); sum += c; cnt += (c > 0u) ? 1u : 0u; mine = (j == x) ? c : mine; }
        if (sum == G) break;
        __builtin_amdgcn_s_sleep(1);
        if ((++sp & 255u) == 0u) { if (xb_ld(&bar[XB_TMO])) break; if (sp > XB_SPIN_CAP) { atomicAdd(&bar[XB_TMO], 1u); break; } }
    }
    nloc = mine > 0u ? mine : 1u; nx = cnt > 0u ? cnt : 1u;
}
__device__ __forceinline__ void xcd_barrier(const XcdBarrier& b) {
    asm volatile("s_waitcnt vmcnt(0)" ::: "memory");
    __syncthreads();
    if (threadIdx.x == 0) {
        unsigned* bar = b.bar;
        __builtin_amdgcn_s_waitcnt(0);
        unsigned nloc = b.st[0], nx = b.st[1];
        if (nloc == 0u) { xcd_barrier_complete(bar, b.x, nloc, nx); b.st[0] = nloc; b.st[1] = nx; }
        const unsigned old = xb_add(&bar[XB_XSUB(b.x)], 1u);
        const unsigned gen = old / nloc;
        if (old + 1u == (gen + 1u) * nloc) {
            __builtin_amdgcn_fence(__ATOMIC_RELEASE, "agent");
            asm volatile("s_waitcnt vmcnt(0)" ::: "memory");
            const unsigned og = xb_add(&bar[XB_TOP], 1u);
            const unsigned tg = og / nx;
            if (og + 1u == (tg + 1u) * nx) xb_add(&bar[XB_TOPGEN], 1u);
            else XB_SPIN(xb_ld(&bar[XB_TOPGEN]) == tg, bar);
            __builtin_amdgcn_fence(__ATOMIC_ACQUIRE, "agent");
            xb_add(&bar[XB_XGEN(b.x)], 1u);
            asm volatile("s_waitcnt vmcnt(0)" ::: "memory");
        } else {
            XB_SPIN(xb_ld(&bar[XB_XGEN(b.x)]) == gen, bar);
            __builtin_amdgcn_fence(__ATOMIC_ACQUIRE, "agent");
            asm volatile("s_waitcnt vmcnt(0)" ::: "memory");
        }
    }
    __syncthreads();
}

struct Frame {
    LAS unsigned char* lds;
    int tid, lane, wave;
    int vcu, G;
};
__device__ __forceinline__ float wave_sum(float v) {
#pragma unroll
    for (int o = 1; o < 64; o <<= 1) v += __shfl_xor(v, o);
    return v;
}

template <int MAP> __device__ __forceinline__ int tr_drow(int n, int p0) {
    if (MAP == 0) return p0 + n;
    const int j = n < DFF ? n : n - DFF; return p0 + (j >> 7) * 256 + (n < DFF ? 0 : 128) + (j & 127);
}
template <int MAP> __device__ __forceinline__ void tr_item(const float* W, int ld_src, int N, bf16* WT, int ld_dst, int p0, int coff, LAS float* scr, int item, int lane, float sc = 1.0f, const float* gk = nullptr) {
    const int nblk = N / 32, kb = item / nblk, nb = item % nblk, k0 = 64 * kb, n0 = 32 * nb;
#pragma unroll
    for (int i = 0; i < 8; ++i) { const int kk = 8 * i + (lane >> 3), n4 = (lane & 7) * 4;
        const f32x4 v = *(const GAS f32x4*)(W + (size_t)(k0 + kk) * ld_src + n0 + n4); const float s_ = gk ? sc * gk[k0 + kk] : sc;
        scr[kk * 33 + n4] = v.x * s_; scr[kk * 33 + n4 + 1] = v.y * s_; scr[kk * 33 + n4 + 2] = v.z * s_; scr[kk * 33 + n4 + 3] = v.w * s_; }
    LDS_WAIT(); asm volatile("" ::: "memory");
    const int c = lane & 7;
#pragma unroll
    for (int j = 0; j < 4; ++j) { const int n = (lane >> 3) + 8 * j; const LAS float* s = scr + (8 * c) * 33 + n;
        v4u o; o.x = pk2(s[0 * 33], s[1 * 33]); o.y = pk2(s[2 * 33], s[3 * 33]); o.z = pk2(s[4 * 33], s[5 * 33]); o.w = pk2(s[6 * 33], s[7 * 33]);
        *(GAS v4u*)(WT + (size_t)tr_drow<MAP>(n0 + n, p0) * ld_dst + coff + k0 + 8 * c) = o; }
    LDS_WAIT(); asm volatile("" ::: "memory");
}
struct Args { const float* in[33]; float* out; unsigned char* ws; int ph_lo, ph_hi; };
enum { I_X = 0, I_MEM, I_NORM_MIX, I_W_IN, I_SGU_G, I_SGU_W, I_SGU_B, I_CONV_W, I_CONV_B, I_RG_WA, I_RG_BA, I_RG_WX, I_RG_BX, I_RG_LAMBDA, I_SWA_SINKS, I_FOX_BF, I_W_BRANCH, I_W_GATE, I_B_GATE, I_W_OUT,
       I_NORM_CROSS, I_NORM_MEM, I_WQ_C, I_WKV_C, I_WO_C, I_NORM_FFN, I_DENSE_W13, I_DENSE_W2, I_ROUTER_W, I_ROUTER_B, I_MOE_W13, I_MOE_W2, I_NORM_FINAL };

__device__ __forceinline__ void p0_prologue(const Frame& F, const __attribute__((address_space(4))) Args* ap) {
    const __attribute__((address_space(4))) Args& a = *ap;
    LAS float* scr = (LAS float*)(F.lds + RING_OFF + F.wave * 16384);
    const int gw = F.vcu * NWAVES + F.wave, NGW = F.G * NWAVES;
    unsigned char* ws = a.ws;
    int it = gw;
#define TR_JOB(MAP, src, ldsrc, K, N, dst, lddst, p0, coff) { const int ni_ = ((K) / 64) * ((N) / 32); for (; it < ni_; it += NGW) tr_item<MAP>((src), (ldsrc), (N), (dst), (lddst), (p0), (coff), scr, it, F.lane); it -= ni_; }
    for (int l = 0; l < DEPTH; ++l) {
        TR_JOB(0, a.in[I_W_IN] + (size_t)l * DM * DIN, DIN, DM, NPROJ, (bf16*)(ws + WS_WIN) + (size_t)l * NPROJ * DM, DM, 0, 0)
        for (int br = 0; br < 4; ++br) {
            TR_JOB(0, a.in[I_W_GATE] + (size_t)(l * 4 + br) * DM * DM, DM, DM, DM, (bf16*)(ws + WS_WG) + (size_t)(l * 4 + br) * DM * DM, DM, 0, 0)
            TR_JOB(0, a.in[I_W_BRANCH] + (size_t)(l * 4 + br) * 512 * DM, DM, 512, DM, (bf16*)(ws + WS_WB) + (size_t)(l * 4 + br) * DM * DM, DM, 0, 0)
        }
        TR_JOB(0, a.in[I_W_OUT] + (size_t)l * DM * DM, DM, DM, DM, (bf16*)(ws + WS_WOUT) + (size_t)l * DM * DM, DM, 0, 0)
        TR_JOB(0, a.in[I_WKV_C] + (size_t)l * DM * 1024, 1024, DM, 1024, (bf16*)(ws + WS_WKV) + (size_t)l * 1024 * DM, DM, 0, 0)
        TR_JOB(0, a.in[I_WO_C] + (size_t)l * 512 * DM, DM, 512, DM, (bf16*)(ws + WS_WOC) + (size_t)l * DM * 512, 512, 0, 0)
        { const int ni_ = (DM / 64) * (512 / 32); for (; it < ni_; it += NGW) tr_item<0>(a.in[I_WQ_C] + (size_t)l * DM * 512, 512, 512, (bf16*)(ws + WS_WQ) + (size_t)l * 512 * DM, DM, 0, 0, scr, it, F.lane, 0.08838834764831845f * LOG2E, a.in[I_NORM_CROSS] + (size_t)l * DM); it -= ni_; }
        for (int h = 0; h < 4; ++h) {
            TR_JOB(0, a.in[I_RG_WA] + (size_t)(l * 4 + h) * 128 * 128, 128, 128, 128, (bf16*)(ws + WS_WLRU) + (size_t)l * 1024 * 128, 128, h * 256, 0)
            TR_JOB(0, a.in[I_RG_WX] + (size_t)(l * 4 + h) * 128 * 128, 128, 128, 128, (bf16*)(ws + WS_WLRU) + (size_t)l * 1024 * 128, 128, h * 256 + 128, 0)
        }
    }
    { const int ni_ = (DM / 64) * (2 * DFF / 32); for (; it < ni_; it += NGW) tr_item<1>(a.in[I_DENSE_W13], 2 * DFF, 2 * DFF, (bf16*)(ws + WS_W13), DM, 0, 0, scr, it, F.lane, 1.0f, a.in[I_NORM_FFN]); it -= ni_; }
    TR_JOB(0, a.in[I_DENSE_W2], DM, DFF, DM, (bf16*)(ws + WS_W2), DFF, 0, 0)
#undef TR_JOB
    const size_t gt = (size_t)F.vcu * (NWAVES * 64) + F.tid, NGT = (size_t)F.G * NWAVES * 64;
    for (size_t i = gt; i < (size_t)DEPTH * 4 * 128 * 128 / 4; i += NGT) { const f32x4 v = ((const GAS f32x4*)a.in[I_SGU_W])[i]; const int t = (int)((i >> 5) & 127), s0 = (int)(i & 31) * 4;
        v2u o; o.x = pk2(s0 <= t ? v.x : 0.f, s0 + 1 <= t ? v.y : 0.f); o.y = pk2(s0 + 2 <= t ? v.z : 0.f, s0 + 3 <= t ? v.w : 0.f); ((GAS v2u*)(ws + WS_WSGU))[i] = o; }
    for (int r = gw; r < DEPTH * BATCH * MEMLEN; r += NGW) { const int l = r / (BATCH * MEMLEN), row = r % (BATCH * MEMLEN);
        const GAS f32x4* xr = (const GAS f32x4*)(a.in[I_MEM] + (size_t)row * DM) + F.lane; const GAS f32x4* gr = (const GAS f32x4*)(a.in[I_NORM_MEM] + (size_t)l * DM) + F.lane;
        f32x4 v[4]; float s = 0.f;
#pragma unroll
        for (int j = 0; j < 4; ++j) { v[j] = xr[64 * j]; s += (v[j].x * v[j].x + v[j].y * v[j].y) + (v[j].z * v[j].z + v[j].w * v[j].w); }
        const float rstd = 1.f / sqrtf(wave_sum(s) * (1.f / DM) + EPS);
        GAS v2u* o8 = (GAS v2u*)(ws + WS_MEMN + (size_t)r * DM * 2) + F.lane;
#pragma unroll
        for (int j = 0; j < 4; ++j) { const f32x4 g = gr[64 * j]; v2u o; o.x = pk2(v[j].x * rstd * g.x, v[j].y * rstd * g.y); o.y = pk2(v[j].z * rstd * g.z, v[j].w * rstd * g.w); o8[64 * j] = o; } }
}

__device__ __forceinline__ void moe_convert_phase(const Frame& F, const __attribute__((address_space(4))) Args* ap) {
    const __attribute__((address_space(4))) Args& a = *ap;
    LAS float* scr = (LAS float*)(F.lds + RING_OFF + F.wave * 16384);
    const int gw = F.vcu * NWAVES + F.wave, NGW = F.G * NWAVES;
    unsigned char* ws = a.ws;
    int it = gw;
#define TR_JOB(MAP, src, ldsrc, K, N, dst, lddst, p0, coff) { const int ni_ = ((K) / 64) * ((N) / 32); for (; it < ni_; it += NGW) tr_item<MAP>((src), (ldsrc), (N), (dst), (lddst), (p0), (coff), scr, it, F.lane); it -= ni_; }
    for (int e = 0; e < NE; ++e) {
        TR_JOB(1, a.in[I_MOE_W13] + (size_t)e * DM * 2 * DFF, 2 * DFF, DM, 2 * DFF, (bf16*)(ws + WS_MW13), DM, e * 2 * DFF, 0)
        TR_JOB(0, a.in[I_MOE_W2] + (size_t)e * DFF * DM, DM, DFF, DM, (bf16*)(ws + WS_MW2) + (size_t)e * DM * DFF, DFF, 0, 0)
    }
#undef TR_JOB
}

template <int MODE, bool IN_F32> __device__ __forceinline__ void norm_phase(const Frame& F, const void* hin, const float* gain, bf16* XN, const float* W8, int w8_ld, const float* b8, unsigned char* ws) {
    LAS float* rowv = (LAS float*)(F.lds + RING_OFF);
    LAS float* segt = rowv + 256 * 8;
    LAS int* lcnt = (LAS int*)(segt + 64);
    f32x4 g4[4];
#pragma unroll
    for (int j = 0; j < 4; ++j) g4[j] = ((const GAS f32x4*)gain)[F.lane + 64 * j];
    float w8[8][16];
    if (MODE != 0) {
        LAS float* wl = (LAS float*)(F.lds + RING_OFF + 16384);
        for (int q = F.tid; q < 2048; q += NWAVES * 64) { const int k = q >> 1, hf = (q & 1) * 4; *(LAS f32x4*)(wl + k * 8 + hf) = *(const GAS f32x4*)(W8 + (size_t)k * w8_ld + hf); }
        LDS_WAIT(); __syncthreads();
#pragma unroll
        for (int j = 0; j < 4; ++j)
#pragma unroll
            for (int i = 0; i < 4; ++i) { const f32x4 a = *(const LAS f32x4*)(wl + (4 * F.lane + 256 * j + i) * 8), b = *(const LAS f32x4*)(wl + (4 * F.lane + 256 * j + i) * 8 + 4);
                w8[0][j * 4 + i] = a[0]; w8[1][j * 4 + i] = a[1]; w8[2][j * 4 + i] = a[2]; w8[3][j * 4 + i] = a[3]; w8[4][j * 4 + i] = b[0]; w8[5][j * 4 + i] = b[1]; w8[6][j * 4 + i] = b[2]; w8[7][j * 4 + i] = b[3]; }
        LDS_WAIT(); __syncthreads();
    }
    for (int c = blockIdx.x; c < M / 256; c += F.G) {
        if (MODE == 2) { if (F.tid < 16) lcnt[F.tid] = 0; }
        constexpr int RB = (MODE == 0) ? 4 : 2;
        for (int rr = 0; rr < 32; rr += RB) {
            f32x4 v[RB][4];
#pragma unroll
            for (int q = 0; q < RB; ++q) { const size_t row = (size_t)c * 256 + F.wave * 32 + rr + q;
                if (IN_F32) { const GAS f32x4* xr = (const GAS f32x4*)((const float*)hin + row * DM) + F.lane;
#pragma unroll
                    for (int j = 0; j < 4; ++j) v[q][j] = xr[64 * j];
                } else { const GAS v2u* xr = (const GAS v2u*)((const bf16*)hin + row * DM) + F.lane;
#pragma unroll
                    for (int j = 0; j < 4; ++j) { const v2u w = xr[64 * j]; v[q][j] = (f32x4){bflo(w.x), bfhi(w.x), bflo(w.y), bfhi(w.y)}; } } }
#pragma unroll
            for (int q = 0; q < RB; ++q) { const int rl = F.wave * 32 + rr + q; const size_t row = (size_t)c * 256 + rl; float s = 0.f;
#pragma unroll
                for (int j = 0; j < 4; ++j) s += (v[q][j].x * v[q][j].x + v[q][j].y * v[q][j].y) + (v[q][j].z * v[q][j].z + v[q][j].w * v[q][j].w);
                const float rstd = 1.f / sqrtf(wave_sum(s) * (1.f / DM) + EPS);
                GAS v2u* o8 = (GAS v2u*)(XN + row * DM) + F.lane;
#pragma unroll
                for (int j = 0; j < 4; ++j) { v[q][j] = v[q][j] * rstd * g4[j]; v2u o; o.x = pk2(v[q][j].x, v[q][j].y); o.y = pk2(v[q][j].z, v[q][j].w); o8[64 * j] = o; }
                if (MODE != 0) {
                    float d[8];
#pragma unroll
                    for (int e = 0; e < 8; ++e) { float qq = 0.f;
#pragma unroll
                        for (int j = 0; j < 4; ++j) qq += (v[q][j].x * w8[e][j * 4] + v[q][j].y * w8[e][j * 4 + 1]) + (v[q][j].z * w8[e][j * 4 + 2] + v[q][j].w * w8[e][j * 4 + 3]);
                        d[e] = wave_sum(qq); }
                    if (F.lane == 0) {
#pragma unroll
                        for (int e = 0; e < 8; ++e) rowv[rl * 8 + e] = d[e] + b8[e]; }
                } }
        }
        if (MODE == 1) {
            LDS_WAIT(); __syncthreads();
            if (F.tid < 64) { const int hd = F.tid & 7, sg = F.tid >> 3; float run = 0.f;
                for (int t = 0; t < 32; ++t) { const int idx = (sg * 32 + t) * 8 + hd; const float z = rowv[idx]; const float ls = (fminf(z, 0.f) - log1pf(__expf(-fabsf(z)))) * LOG2E; run += ls; rowv[idx] = run; }
                segt[sg * 8 + hd] = run; }
            LDS_WAIT(); __syncthreads();
            { const int rl = F.tid >> 1, h0 = (F.tid & 1) * 4; f32x4 o;
#pragma unroll
                for (int i = 0; i < 4; ++i) { float p = 0.f; for (int sg = 0; sg < (rl >> 5); ++sg) p += segt[sg * 8 + h0 + i]; o[i] = rowv[rl * 8 + h0 + i] + p; }
                *(GAS f32x4*)((float*)(ws + WS_LC) + ((size_t)c * 256 + rl) * 8 + h0) = o;
                if (rl == 255) *(GAS f32x4*)((float*)(ws + WS_TOT) + (size_t)c * 8 + h0) = o; }
            LDS_WAIT(); __syncthreads();
        }
        if (MODE == 2) {
            LDS_WAIT(); __syncthreads();
            if (F.tid < 256) { float lg[8];
#pragma unroll
                for (int e = 0; e < 8; ++e) lg[e] = rowv[F.tid * 8 + e];
                int e0 = 0; float v0 = lg[0];
#pragma unroll
                for (int e = 1; e < 8; ++e) if (lg[e] > v0) { v0 = lg[e]; e0 = e; }
                int e1 = -1; float v1 = -INFINITY;
#pragma unroll
                for (int e = 0; e < 8; ++e) if (e != e0 && lg[e] > v1) { v1 = lg[e]; e1 = e; }
                const float w0 = 1.0f / (1.0f + __expf(v1 - v0)), w1 = 1.0f - w0;
                v4u o; o.x = (unsigned)e0; o.y = (unsigned)e1; o.z = __float_as_uint(w0); o.w = __float_as_uint(w1);
                *(GAS v4u*)(ws + WS_ROUTE + ((size_t)c * 256 + F.tid) * 16) = o;
                atomicAdd((int*)lcnt + e0, 1); atomicAdd((int*)lcnt + 8 + e1, 1); }
            LDS_WAIT(); __syncthreads();
            if (F.tid < 16) { const int n = lcnt[F.tid]; ((int*)(ws + WS_MOE + MOE_WGCNT))[c * 16 + F.tid] = n; __hip_atomic_fetch_add((int*)(ws + WS_CTL) + CW_MOECNT + F.tid, n, RLX_AGENT); }
            LDS_WAIT(); __syncthreads();
        }
    }
}

__device__ __forceinline__ void conv_phase(const Frame& F, const bf16* PROJ, const float* cw, const float* cb, bf16* XC) {
    const int gw = F.vcu * NWAVES + F.wave, NGW = F.G * NWAVES, c = F.lane * 8;
    float w[4][8], b[8];
#pragma unroll
    for (int k = 0; k < 4; ++k) { const f32x4 w0 = *(const GAS f32x4*)(cw + k * 512 + c), w1 = *(const GAS f32x4*)(cw + k * 512 + c + 4);
#pragma unroll
        for (int j = 0; j < 4; ++j) { w[k][j] = w0[j]; w[k][4 + j] = w1[j]; } }
    { const f32x4 b0 = *(const GAS f32x4*)(cb + c), b1 = *(const GAS f32x4*)(cb + c + 4);
#pragma unroll
        for (int j = 0; j < 4; ++j) { b[j] = b0[j]; b[4 + j] = b1[j]; } }
#pragma unroll 1
    for (int run = gw; run < M / 16; run += NGW) { const int t0 = run * 16; const bool head = (t0 & (SEQ - 1)) == 0;
        const bf16* src = PROJ + (size_t)t0 * PP + C_BX + c;
        v4u x0 = (v4u){0u, 0u, 0u, 0u}, x1 = x0, x2 = x0;
        if (!head) { x0 = *(const GAS v4u*)(src - 3 * (size_t)PP); x1 = *(const GAS v4u*)(src - 2 * (size_t)PP); x2 = *(const GAS v4u*)(src - (size_t)PP); }
#pragma unroll 4
        for (int r = 0; r < 16; ++r) { const v4u x3 = *(const GAS v4u*)(src + (size_t)r * PP);
            float acc[8];
#pragma unroll
            for (int j = 0; j < 8; ++j) acc[j] = b[j];
#define CONV_TAP(k, V_) acc[0] += w[k][0] * bflo(V_.x); acc[1] += w[k][1] * bfhi(V_.x); acc[2] += w[k][2] * bflo(V_.y); acc[3] += w[k][3] * bfhi(V_.y); acc[4] += w[k][4] * bflo(V_.z); acc[5] += w[k][5] * bfhi(V_.z); acc[6] += w[k][6] * bflo(V_.w); acc[7] += w[k][7] * bfhi(V_.w);
            CONV_TAP(0, x0) CONV_TAP(1, x1) CONV_TAP(2, x2) CONV_TAP(3, x3)
#undef CONV_TAP
            v4u o; o.x = pk2(acc[0], acc[1]); o.y = pk2(acc[2], acc[3]); o.z = pk2(acc[4], acc[5]); o.w = pk2(acc[6], acc[7]);
            *(GAS v4u*)(XC + (size_t)(t0 + r) * 512 + c) = o;
            x0 = x1; x1 = x2; x2 = x3; }
    }
}

__device__ __forceinline__ void small_tile(const bf16* A, int lda, const bf16* Bt, int ldb, float scale, bf16* C, int ldc, int lane) {
    const int r31 = lane & 31, hi = lane >> 5; f32x16 acc = {};
#pragma unroll
    for (int ks = 0; ks < 8; ++ks) { const bf16x8 av = *(const GAS bf16x8*)(A + (size_t)r31 * lda + ks * 16 + 8 * hi); const bf16x8 bv = *(const GAS bf16x8*)(Bt + (size_t)r31 * ldb + ks * 16 + 8 * hi);
        acc = __builtin_amdgcn_mfma_f32_32x32x16_bf16(av, bv, acc, 0, 0, 0); }
#pragma unroll
    for (int r = 0; r < 16; ++r) { const int row = (r & 3) + 8 * (r >> 2) + 4 * hi; C[(size_t)row * ldc + r31] = (bf16)f2bf(acc[r] * scale); }
}
__device__ __forceinline__ void crossprep_phase(const Frame& F, const bf16* KV  , const bf16* WQ  , const bf16* WOC  , bf16* WQK, bf16* VWO) {
    const int gw = F.vcu * NWAVES + F.wave, NGW = F.G * NWAVES;
    const float qsx = 0.08838834764831845f * LOG2E;
    for (int T = gw; T < 16384; T += NGW) {
        const int which = T >> 13, t = T & 8191, bh = t >> 8, b = bh >> 2, hd = bh & 3;
        if (which == 0) { const int it = (t >> 5) & 7, jt = t & 31;
            small_tile(KV + (size_t)(b * 256 + it * 32) * 1024 + hd * 128, 1024, WQ + (size_t)(jt * 32) * 512 + hd * 128, 512, qsx, WQK + (size_t)b * DM * DM + (size_t)(hd * 256 + it * 32) * DM + jt * 32, DM, F.lane);
        } else { const int it = (t >> 3) & 31, jt = t & 7;
            small_tile(WOC + (size_t)(it * 32) * 512 + hd * 128, 512, KV + (size_t)(b * 256 + jt * 32) * 1024 + 512 + hd * 128, 1024, 1.0f, VWO + (size_t)b * DM * DM + (size_t)(it * 32) * DM + hd * 256 + jt * 32, DM, F.lane); }
    }
}

__device__ __forceinline__ void xattn_phase(const Frame& F, bf16* QO, const bf16* KV, bf16* OUT = nullptr) {
    if (!OUT) OUT = QO;
    typedef float f32x2v __attribute__((ext_vector_type(2)));
    constexpr int VTP = 260;
    LAS unsigned char* Ks = F.lds;
    LAS bf16* VT = (LAS bf16*)(F.lds + 65536);
    LAS float* lsc = (LAS float*)(F.lds + 65536 + 128 * VTP * 2) + F.wave * 32;
    const int r32 = F.lane & 31, hi = F.lane >> 5;
    for (int item = F.vcu; item < 256; item += F.G) {
        const int bh = item >> 3, b = bh >> 2, hd = bh & 3;
        __syncthreads();
#pragma unroll
        for (int i = 0; i < 8; ++i) { const int c = F.tid + 512 * i, key = c >> 4, ch = c & 15; const bf16* src = KV + (size_t)(b * 256 + key) * 1024 + hd * 128 + ch * 8;
            const v4u kx = *(const GAS v4u*)src; const v4u vx = *(const GAS v4u*)(src + 512);
            *(LAS v4u*)(Ks + key * 256 + ((ch ^ (key & 15)) << 4)) = kx;
            LAS bf16* vt = VT + (ch * 8) * VTP + key;
            vt[0 * VTP] = (bf16)(vx.x & 0xffffu); vt[1 * VTP] = (bf16)(vx.x >> 16); vt[2 * VTP] = (bf16)(vx.y & 0xffffu); vt[3 * VTP] = (bf16)(vx.y >> 16);
            vt[4 * VTP] = (bf16)(vx.z & 0xffffu); vt[5 * VTP] = (bf16)(vx.z >> 16); vt[6 * VTP] = (bf16)(vx.w & 0xffffu); vt[7 * VTP] = (bf16)(vx.w >> 16); }
        LDS_WAIT(); __syncthreads();
        for (int qi = 0; qi < 4; ++qi) {
            const size_t row0 = (size_t)b * SEQ + (size_t)((item & 7) * 4 + qi) * 256 + F.wave * 32;
            bf16* qp = QO + (row0 + r32) * 512 + hd * 128 + hi * 8;
            bf16x8 qf[8];
#pragma unroll
            for (int d0 = 0; d0 < 8; ++d0) qf[d0] = *(const GAS bf16x8*)(qp + d0 * 16);
            f32x16 s[8];
#pragma unroll
            for (int kb = 0; kb < 8; ++kb) { s[kb] = f32x16{}; const int key = kb * 32 + r32;
#pragma unroll
                for (int d0 = 0; d0 < 8; ++d0) { const bf16x8 kf = *(const LAS bf16x8*)(Ks + key * 256 + (((2 * d0 + hi) ^ (key & 15)) << 4)); s[kb] = __builtin_amdgcn_mfma_f32_32x32x16_bf16(kf, qf[d0], s[kb], 0, 0, 0); } }
            float mx = -INFINITY;
#pragma unroll
            for (int kb = 0; kb < 8; ++kb)
#pragma unroll
                for (int r = 0; r < 16; ++r) mx = fmaxf(mx, s[kb][r]);
            mx = fmaxf(mx, __shfl_xor(mx, 32));
            float sum = 0.f;
#pragma unroll
            for (int kb = 0; kb < 8; ++kb)
#pragma unroll
                for (int r = 0; r < 16; ++r) { const float pv_ = __builtin_amdgcn_exp2f(s[kb][r] - mx); s[kb][r] = pv_; sum += pv_; }
            sum += __shfl_xor(sum, 32);
            bf16x8 pa[16];
#pragma unroll
            for (int kb = 0; kb < 8; ++kb)
#pragma unroll
                for (int sp = 0; sp < 2; ++sp) { pg8::u32x4 pw; pw.x = pg8::cvt_pk_bf16(s[kb][8 * sp + 0], s[kb][8 * sp + 1]); pw.y = pg8::cvt_pk_bf16(s[kb][8 * sp + 2], s[kb][8 * sp + 3]); pw.z = pg8::cvt_pk_bf16(s[kb][8 * sp + 4], s[kb][8 * sp + 5]); pw.w = pg8::cvt_pk_bf16(s[kb][8 * sp + 6], s[kb][8 * sp + 7]);
                    pa[kb * 2 + sp] = __builtin_bit_cast(bf16x8, pw); }
            asm volatile("" ::: "memory");
            f32x16 o[4];
#pragma unroll
            for (int db = 0; db < 4; ++db) o[db] = f32x16{};
#pragma unroll
            for (int ks = 0; ks < 16; ++ks) { const int kbase = (ks >> 1) * 32 + 16 * (ks & 1) + 4 * hi;
#pragma unroll
                for (int db = 0; db < 4; ++db) { const LAS bf16* vp = VT + (db * 32 + r32) * VTP + kbase; const v2u lo = *(const LAS v2u*)vp, hi4 = *(const LAS v2u*)(vp + 8);
                    pg8::u32x4 bw; bw.x = lo.x; bw.y = lo.y; bw.z = hi4.x; bw.w = hi4.y; o[db] = __builtin_amdgcn_mfma_f32_32x32x16_bf16(__builtin_bit_cast(bf16x8, bw), pa[ks], o[db], 0, 0, 0); } }
            { const float inv = __builtin_amdgcn_rcpf(sum); bf16* op = OUT + (row0 + r32) * 512 + hd * 128 + 4 * hi;
#pragma unroll
                for (int db = 0; db < 4; ++db)
#pragma unroll
                    for (int rg = 0; rg < 4; ++rg) { v2u w_; w_.x = pg8::cvt_pk_bf16(o[db][4 * rg] * inv, o[db][4 * rg + 1] * inv); w_.y = pg8::cvt_pk_bf16(o[db][4 * rg + 2] * inv, o[db][4 * rg + 3] * inv); *(GAS v2u*)(op + db * 32 + rg * 8) = w_; } }
        }
    }
    __syncthreads();
}

__device__ __forceinline__ void sgu_phase(const Frame& F, bf16* PROJ, const bf16* WS  , const float* gain  , const float* bs  ) {
    LAS float* rs = (LAS float*)(F.lds + RING_OFF);
    LAS bf16* vT = (LAS bf16*)(F.lds + RING_OFF + 1024);
    LAS bf16* oT = vT + 128 * 136;
    constexpr int VP = 136;
    const int r31 = F.lane & 31, hi = F.lane >> 5;
    for (int ch = blockIdx.x; ch < M / 128; ch += F.G) {
        const size_t t0 = (size_t)ch * 128;
        { v4u x[4];
#pragma unroll
            for (int r4 = 0; r4 < 16; r4 += 4) {
#pragma unroll
                for (int q = 0; q < 4; ++q) x[q] = *(const GAS v4u*)(PROJ + (t0 + F.wave * 16 + r4 + q) * PP + C_AV + F.lane * 8);
#pragma unroll
                for (int q = 0; q < 4; ++q) { float s = bflo(x[q].x) * bflo(x[q].x) + bfhi(x[q].x) * bfhi(x[q].x) + bflo(x[q].y) * bflo(x[q].y) + bfhi(x[q].y) * bfhi(x[q].y) + bflo(x[q].z) * bflo(x[q].z) + bfhi(x[q].z) * bfhi(x[q].z) + bflo(x[q].w) * bflo(x[q].w) + bfhi(x[q].w) * bfhi(x[q].w);
                    s = wave_sum(s); if (F.lane == 0) rs[F.wave * 16 + r4 + q] = 1.f / sqrtf(s * (1.f / 512.f) + EPS); } } }
        LDS_WAIT(); __syncthreads();
        v4u x[4];
#pragma unroll
        for (int i = 0; i < 4; ++i) { const int q = F.tid + 512 * i, s = q >> 4, dc = (q & 15) * 8; x[i] = *(const GAS v4u*)(PROJ + (t0 + s) * PP + C_AV + dc); }
#pragma unroll 1
        for (int g = 0; g < 4; ++g) {
            v4u uu[4], xn[4];
#pragma unroll
            for (int i = 0; i < 4; ++i) { const int q = F.tid + 512 * i, t = q >> 4, dc = (q & 15) * 8; uu[i] = *(const GAS v4u*)(PROJ + (t0 + t) * PP + C_AU + g * 128 + dc); }
            { const int gn = g < 3 ? g + 1 : 3;
#pragma unroll
                for (int i = 0; i < 4; ++i) { const int q = F.tid + 512 * i, s = q >> 4, dc = (q & 15) * 8; xn[i] = *(const GAS v4u*)(PROJ + (t0 + s) * PP + C_AV + gn * 128 + dc); } }
            {
#pragma unroll
                for (int i = 0; i < 4; ++i) { const int q = F.tid + 512 * i, s = q >> 4, dc = (q & 15) * 8; const float r = rs[s]; const f32x4 g0 = *(const GAS f32x4*)(gain + g * 128 + dc), g1 = *(const GAS f32x4*)(gain + g * 128 + dc + 4);
                    vT[(dc + 0) * VP + s] = (bf16)f2bf(bflo(x[i].x) * r * g0[0]); vT[(dc + 1) * VP + s] = (bf16)f2bf(bfhi(x[i].x) * r * g0[1]); vT[(dc + 2) * VP + s] = (bf16)f2bf(bflo(x[i].y) * r * g0[2]); vT[(dc + 3) * VP + s] = (bf16)f2bf(bfhi(x[i].y) * r * g0[3]);
                    vT[(dc + 4) * VP + s] = (bf16)f2bf(bflo(x[i].z) * r * g1[0]); vT[(dc + 5) * VP + s] = (bf16)f2bf(bfhi(x[i].z) * r * g1[1]); vT[(dc + 6) * VP + s] = (bf16)f2bf(bflo(x[i].w) * r * g1[2]); vT[(dc + 7) * VP + s] = (bf16)f2bf(bfhi(x[i].w) * r * g1[3]); } }
            const int tt = F.wave >> 1; const bf16* wg = WS + (size_t)g * 128 * 128 + (size_t)(tt * 32 + r31) * 128 + 8 * hi;
            bf16x8 av[8];
#pragma unroll
            for (int ks = 0; ks < 8; ++ks) if (ks <= 2 * tt + 1) av[ks] = *(const GAS bf16x8*)(wg + ks * 16);
            LDS_WAIT(); __syncthreads();
#pragma unroll
            for (int dq = 0; dq < 2; ++dq) { const int dd = (F.wave & 1) * 2 + dq; f32x16 acc = {};
#pragma unroll
                for (int ks = 0; ks < 8; ++ks) if (ks <= 2 * tt + 1) { const bf16x8 bv = *(const LAS bf16x8*)(vT + (dd * 32 + r31) * VP + ks * 16 + 8 * hi);
                    acc = __builtin_amdgcn_mfma_f32_32x32x16_bf16(av[ks], bv, acc, 0, 0, 0); }
#pragma unroll
                for (int r = 0; r < 16; ++r) { const int t = tt * 32 + (r & 3) + 8 * (r >> 2) + 4 * hi; oT[t * VP + dd * 32 + r31] = (bf16)f2bf(acc[r] + bs[g * 128 + t]); } }
            LDS_WAIT(); __syncthreads();
#pragma unroll
            for (int i = 0; i < 4; ++i) { const int q = F.tid + 512 * i, t = q >> 4, dc = (q & 15) * 8; bf16* up = PROJ + (t0 + t) * PP + C_AU + g * 128 + dc;
                const v4u u = uu[i]; const v4u m = *(const LAS v4u*)(oT + t * VP + dc); v4u o;
                o.x = pk2(bflo(u.x) * bflo(m.x), bfhi(u.x) * bfhi(m.x)); o.y = pk2(bflo(u.y) * bflo(m.y), bfhi(u.y) * bfhi(m.y)); o.z = pk2(bflo(u.z) * bflo(m.z), bfhi(u.z) * bfhi(m.z)); o.w = pk2(bflo(u.w) * bflo(m.w), bfhi(u.w) * bfhi(m.w));
                *(GAS v4u*)up = o; }
#pragma unroll
            for (int i = 0; i < 4; ++i) x[i] = xn[i];
        }
        LDS_WAIT(); __syncthreads();
    }
}

__device__ __forceinline__ void lru_gate_phase(const Frame& F, const bf16* XC, const bf16* W  , bf16* PROJ, const float* ba, const float* bx, const float* lam, float* LA, float* LH, float* LA8, float* LH8) {
    const int r31 = F.lane & 31, hi = F.lane >> 5;
    LAS bf16* so = (LAS bf16*)(F.lds + RING_OFF) + F.wave * 8192;
    LAS bf16* sg = so + 4096;
#pragma unroll 1
    for (int c = blockIdx.x; c < M / 256; c += F.G) {
        const size_t r0 = (size_t)c * 256 + F.wave * 32;
#pragma unroll 1
        for (int h = 0; h < 4; ++h) {
            bf16x8 af[8];
#pragma unroll
            for (int ks = 0; ks < 8; ++ks) af[ks] = *(const GAS bf16x8*)(XC + (r0 + r31) * 512 + h * 128 + ks * 16 + 8 * hi);
#pragma unroll 1
            for (int j = 0; j < 4; ++j) {
                const bf16* wr = W + (size_t)(h * 256 + j * 32 + r31) * 128 + 8 * hi; f32x16 ar = {}, ai = {};
                bf16x8 b0[8], b1[8];
#pragma unroll
                for (int ks = 0; ks < 8; ++ks) { b0[ks] = *(const GAS bf16x8*)(wr + ks * 16); b1[ks] = *(const GAS bf16x8*)(wr + 128 * 128 + ks * 16); }
#pragma unroll
                for (int ks = 0; ks < 8; ++ks) { ar = __builtin_amdgcn_mfma_f32_32x32x16_bf16(af[ks], b0[ks], ar, 0, 0, 0); ai = __builtin_amdgcn_mfma_f32_32x32x16_bf16(af[ks], b1[ks], ai, 0, 0, 0); }
                const int chl = j * 32 + r31, ch = h * 128 + chl; const float bav = ba[ch], bxv = bx[ch], sp = -8.0f * LOG2E * log1pf(__expf(-lam[ch]));
#pragma unroll
                for (int r = 0; r < 16; ++r) { const int rl = (r & 3) + 8 * (r >> 2) + 4 * hi;
                    const float rg = pg8::fast_sigmoid(ar[r] + bav), ig = pg8::fast_sigmoid(ai[r] + bxv); const float a = __builtin_amdgcn_exp2f(rg * sp); const float om = 1.0f - a;
                    so[rl * 128 + chl] = (bf16)f2bf(om); sg[rl * 128 + chl] = (bf16)f2bf(ig * __builtin_sqrtf(om * (1.0f + a))); }
            }
            LDS_WAIT();
            { float A8[8], H8[8]; const int cc = (F.lane & 15) * 8, rb = (F.lane >> 4) * 8;
#pragma unroll
                for (int j = 0; j < 8; ++j) { A8[j] = 1.f; H8[j] = 0.f; }
#pragma unroll
                for (int q8 = 0; q8 < 8; ++q8) { const int rl = rb + q8; const size_t row = r0 + rl;
                    const v4u x = *(const GAS v4u*)(XC + row * 512 + h * 128 + cc); const v4u o = *(const LAS v4u*)(so + rl * 128 + cc); const v4u g = *(const LAS v4u*)(sg + rl * 128 + cc); v4u y;
                    y.x = pk2(bflo(x.x) * bflo(g.x), bfhi(x.x) * bfhi(g.x)); y.y = pk2(bflo(x.y) * bflo(g.y), bfhi(x.y) * bfhi(g.y)); y.z = pk2(bflo(x.z) * bflo(g.z), bfhi(x.z) * bfhi(g.z)); y.w = pk2(bflo(x.w) * bflo(g.w), bfhi(x.w) * bfhi(g.w));
                    *(GAS v4u*)(PROJ + row * PP + C_OM + h * 128 + cc) = o; *(GAS v4u*)(PROJ + row * PP + C_INP + h * 128 + cc) = y;
                    const float av[8] = {1.f - bflo(o.x), 1.f - bfhi(o.x), 1.f - bflo(o.y), 1.f - bfhi(o.y), 1.f - bflo(o.z), 1.f - bfhi(o.z), 1.f - bflo(o.w), 1.f - bfhi(o.w)};
                    const float iv[8] = {bflo(y.x), bfhi(y.x), bflo(y.y), bfhi(y.y), bflo(y.z), bfhi(y.z), bflo(y.w), bfhi(y.w)};
#pragma unroll
                    for (int j = 0; j < 8; ++j) { H8[j] = av[j] * H8[j] + iv[j]; A8[j] *= av[j]; } }
#pragma unroll
                for (int st = 16; st <= 32; st <<= 1) { const bool early = (F.lane & st) == 0;
#pragma unroll
                    for (int j = 0; j < 8; ++j) { const float Ap = __shfl_xor(A8[j], st), Hp = __shfl_xor(H8[j], st);
                        const float Ae = early ? A8[j] : Ap, He = early ? H8[j] : Hp, Al = early ? Ap : A8[j], Hl = early ? Hp : H8[j];
                        A8[j] = Ae * Al; H8[j] = Al * He + Hl; } }
                if ((F.lane >> 4) == 0) { float* ga = LA8 + ((size_t)c * 8 + F.wave) * 512 + h * 128 + cc; float* gh = LH8 + ((size_t)c * 8 + F.wave) * 512 + h * 128 + cc;
                    *(GAS f32x4*)ga = (f32x4){A8[0], A8[1], A8[2], A8[3]}; *(GAS f32x4*)(ga + 4) = (f32x4){A8[4], A8[5], A8[6], A8[7]};
                    *(GAS f32x4*)gh = (f32x4){H8[0], H8[1], H8[2], H8[3]}; *(GAS f32x4*)(gh + 4) = (f32x4){H8[4], H8[5], H8[6], H8[7]}; } }
            LDS_WAIT();
        }
        __syncthreads();
        { float a = 1.f, hq = 0.f;
#pragma unroll
            for (int w = 0; w < 8; ++w) { const float aw = LA8[((size_t)c * 8 + w) * 512 + F.tid], hw = LH8[((size_t)c * 8 + w) * 512 + F.tid]; hq = aw * hq + hw; a *= aw; }
            LA[c * 512 + F.tid] = a; LH[c * 512 + F.tid] = hq; }
        __syncthreads();
    }
}

__device__ __forceinline__ void lru_pass1(const Frame& F, const bf16* PROJ, float* LA, float* LH, float* LA8, float* LH8) {
    LAS float* sA = (LAS float*)(F.lds + RING_OFF);
    LAS float* sH = sA + 8 * 512;
    for (int c = blockIdx.x; c < M / 256; c += F.G) {
        const bf16* p = PROJ + ((size_t)c * 256 + F.wave * 32) * PP + F.lane * 8;
        float A[8], hh[8];
#pragma unroll
        for (int j = 0; j < 8; ++j) { A[j] = 1.f; hh[j] = 0.f; }
#pragma unroll 8
        for (int t = 0; t < 32; ++t) { const v4u o = *(const GAS v4u*)(p + (size_t)t * PP + C_OM); const v4u x = *(const GAS v4u*)(p + (size_t)t * PP + C_INP);
            const float av[8] = {1.f - bflo(o.x), 1.f - bfhi(o.x), 1.f - bflo(o.y), 1.f - bfhi(o.y), 1.f - bflo(o.z), 1.f - bfhi(o.z), 1.f - bflo(o.w), 1.f - bfhi(o.w)};
            const float iv[8] = {bflo(x.x), bfhi(x.x), bflo(x.y), bfhi(x.y), bflo(x.z), bfhi(x.z), bflo(x.w), bfhi(x.w)};
#pragma unroll
            for (int j = 0; j < 8; ++j) { hh[j] = av[j] * hh[j] + iv[j]; A[j] *= av[j]; } }
        { float* ga = LA8 + ((size_t)c * 8 + F.wave) * 512 + F.lane * 8; float* gh = LH8 + ((size_t)c * 8 + F.wave) * 512 + F.lane * 8;
            *(GAS f32x4*)ga = (f32x4){A[0], A[1], A[2], A[3]}; *(GAS f32x4*)(ga + 4) = (f32x4){A[4], A[5], A[6], A[7]};
            *(GAS f32x4*)gh = (f32x4){hh[0], hh[1], hh[2], hh[3]}; *(GAS f32x4*)(gh + 4) = (f32x4){hh[4], hh[5], hh[6], hh[7]};
#pragma unroll
            for (int j = 0; j < 8; ++j) { sA[F.wave * 512 + F.lane * 8 + j] = A[j]; sH[F.wave * 512 + F.lane * 8 + j] = hh[j]; } }
        LDS_WAIT(); __syncthreads();
        { float a = 1.f, h = 0.f;
#pragma unroll
            for (int w = 0; w < 8; ++w) { const float aw = sA[w * 512 + F.tid], hw = sH[w * 512 + F.tid]; h = aw * h + hw; a *= aw; }
            LA[c * 512 + F.tid] = a; LH[c * 512 + F.tid] = h; }
        LDS_WAIT(); __syncthreads();
    }
}
__device__ __forceinline__ void lru_pass2(const Frame& F, bf16* PROJ, const float* LA, const float* LH, const float* LA8, const float* LH8) {
    LAS float* sC = (LAS float*)(F.lds + RING_OFF);
    for (int c = blockIdx.x; c < M / 256; c += F.G) {
        { float hc = 0.f; const int cb = c & ~31, nprev = c - cb;
            float wa[8], wh[8];
#pragma unroll
            for (int w = 0; w < 8; ++w) { wa[w] = LA8[((size_t)c * 8 + w) * 512 + F.tid]; wh[w] = LH8[((size_t)c * 8 + w) * 512 + F.tid]; }
            float la[32], lh[32];
#pragma unroll
            for (int q = 0; q < 32; ++q) { const bool ok = q < nprev; const int c2 = ok ? cb + q : c; la[q] = LA[c2 * 512 + F.tid]; lh[q] = LH[c2 * 512 + F.tid]; if (!ok) { la[q] = 1.0f; lh[q] = 0.0f; } }
#pragma unroll
            for (int q = 0; q < 32; ++q) hc = la[q] * hc + lh[q];
#pragma unroll
            for (int w = 0; w < 8; ++w) { sC[w * 512 + F.tid] = hc; hc = wa[w] * hc + wh[w]; } }
        LDS_WAIT(); __syncthreads();
        bf16* p = PROJ + ((size_t)c * 256 + F.wave * 32) * PP + F.lane * 8;
        float hh[8];
#pragma unroll
        for (int j = 0; j < 8; ++j) hh[j] = sC[F.wave * 512 + F.lane * 8 + j];
#pragma unroll 8
        for (int t = 0; t < 32; ++t) { const v4u o = *(const GAS v4u*)(p + (size_t)t * PP + C_OM); const v4u x = *(const GAS v4u*)(p + (size_t)t * PP + C_INP); const v4u y = *(const GAS v4u*)(p + (size_t)t * PP + C_BY);
            const float av[8] = {1.f - bflo(o.x), 1.f - bfhi(o.x), 1.f - bflo(o.y), 1.f - bfhi(o.y), 1.f - bflo(o.z), 1.f - bfhi(o.z), 1.f - bflo(o.w), 1.f - bfhi(o.w)};
            const float iv[8] = {bflo(x.x), bfhi(x.x), bflo(x.y), bfhi(x.y), bflo(x.z), bfhi(x.z), bflo(x.w), bfhi(x.w)};
            const float yv[8] = {bflo(y.x), bfhi(y.x), bflo(y.y), bfhi(y.y), bflo(y.z), bfhi(y.z), bflo(y.w), bfhi(y.w)};
#pragma unroll
            for (int j = 0; j < 8; ++j) hh[j] = av[j] * hh[j] + iv[j];
            v4u r; r.x = pk2(hh[0] * yv[0], hh[1] * yv[1]); r.y = pk2(hh[2] * yv[2], hh[3] * yv[3]); r.z = pk2(hh[4] * yv[4], hh[5] * yv[5]); r.w = pk2(hh[6] * yv[6], hh[7] * yv[7]);
            *(GAS v4u*)(p + (size_t)t * PP + C_BY) = r; }
        LDS_WAIT(); __syncthreads();
    }
}

__device__ __forceinline__ void swa_phase(const Frame& F, bf16* PROJ, const float* sinks  ) {
    constexpr int VTP = 388;
    LAS unsigned char* Ks = F.lds;
    LAS bf16* VT = (LAS bf16*)(F.lds + 49152);
    LAS float* lsc = (LAS float*)(F.lds + 49152 + 64 * VTP * 2) + F.wave * 32;
    const int r32 = F.lane & 31, hi = F.lane >> 5;
#pragma unroll 1
    for (int unit = F.vcu; unit < 512; unit += F.G) {
        const int qb = unit & 31, bk = unit >> 5, b = bk >> 1, kvh = bk & 1;
        const long q0 = (long)b * SEQ + (long)qb * 256;
        __syncthreads();
#pragma unroll
        for (int i = 0; i < 6; ++i) { const int c = F.tid + 512 * i, key = c >> 3, ch = c & 7; v4u kx = (v4u){0u, 0u, 0u, 0u}, vx = kx;
            if (qb > 0 || key >= 128) { const bf16* src = PROJ + (size_t)(q0 - 128 + key) * PP + C_CK + kvh * 64 + ch * 8; kx = *(const GAS v4u*)src; vx = *(const GAS v4u*)(src + (C_CV - C_CK)); }
            *(LAS v4u*)(Ks + key * 128 + ((ch ^ (key & 7)) << 4)) = kx;
            LAS bf16* vt = VT + (ch * 8) * VTP + key;
            vt[0 * VTP] = (bf16)(vx.x & 0xffffu); vt[1 * VTP] = (bf16)(vx.x >> 16); vt[2 * VTP] = (bf16)(vx.y & 0xffffu); vt[3 * VTP] = (bf16)(vx.y >> 16);
            vt[4 * VTP] = (bf16)(vx.z & 0xffffu); vt[5 * VTP] = (bf16)(vx.z >> 16); vt[6 * VTP] = (bf16)(vx.w & 0xffffu); vt[7 * VTP] = (bf16)(vx.w >> 16); }
        LDS_WAIT(); __syncthreads();
        const int kw0 = F.wave * 32;
#pragma unroll 1
        for (int g = 0; g < 4; ++g) {
            const int hd = kvh * 4 + g; const float slope2 = exp2f(-(float)(hd + 1)) * LOG2E, sink2 = sinks[hd] * LOG2E;
            bf16* qp = PROJ + (size_t)(q0 + kw0 + r32) * PP + C_CQ + hd * 64 + hi * 8;
            bf16x8 qf[4];
#pragma unroll
            for (int d0 = 0; d0 < 4; ++d0) qf[d0] = *(const GAS bf16x8*)(qp + d0 * 16);
            f32x16 s[5];
#pragma unroll
            for (int kb = 0; kb < 5; ++kb) { s[kb] = f32x16{}; const int key = kw0 + kb * 32 + r32;
#pragma unroll
                for (int d0 = 0; d0 < 4; ++d0) { const bf16x8 kf = *(const LAS bf16x8*)(Ks + key * 128 + (((2 * d0 + hi) ^ (key & 7)) << 4)); s[kb] = __builtin_amdgcn_mfma_f32_32x32x16_bf16(kf, qf[d0], s[kb], 0, 0, 0); } }
            const int dl0 = 4 * hi - r32;
            const int kmin = (qb > 0) ? -1000000 : 128 - (kw0 + 4 * hi);
            float mx = sink2;
#pragma unroll
            for (int kb = 0; kb < 5; ++kb)
#pragma unroll
                for (int r = 0; r < 16; ++r) { const int c = kb * 32 + (r & 3) + 8 * (r >> 2); const int d = dl0 + c; const bool ok = ((unsigned)(d - 1) < 128u) && (c >= kmin);
                    float v = ok ? s[kb][r] - slope2 * (float)(128 - d) : -INFINITY; asm volatile("" : "+v"(v));     s[kb][r] = v; mx = fmaxf(mx, v); }
            mx = fmaxf(mx, __shfl_xor(mx, 32));
            float sum = 0.f;
#pragma unroll
            for (int kb = 0; kb < 5; ++kb)
#pragma unroll
                for (int r = 0; r < 16; ++r) { const float pv_ = __builtin_amdgcn_exp2f(s[kb][r] - mx); s[kb][r] = pv_; sum += pv_; }
            sum += __shfl_xor(sum, 32); sum += __builtin_amdgcn_exp2f(sink2 - mx);
            bf16x8 pa[10];
#pragma unroll
            for (int kb = 0; kb < 5; ++kb)
#pragma unroll
                for (int sp = 0; sp < 2; ++sp) { pg8::u32x4 pw; pw.x = pg8::cvt_pk_bf16(s[kb][8 * sp + 0], s[kb][8 * sp + 1]); pw.y = pg8::cvt_pk_bf16(s[kb][8 * sp + 2], s[kb][8 * sp + 3]); pw.z = pg8::cvt_pk_bf16(s[kb][8 * sp + 4], s[kb][8 * sp + 5]); pw.w = pg8::cvt_pk_bf16(s[kb][8 * sp + 6], s[kb][8 * sp + 7]);
                    pa[kb * 2 + sp] = __builtin_bit_cast(bf16x8, pw); }
            asm volatile("" ::: "memory");
            f32x16 o[2];
            o[0] = f32x16{}; o[1] = f32x16{};
#pragma unroll
            for (int ks = 0; ks < 10; ++ks) { const int kbase = kw0 + (ks >> 1) * 32 + 16 * (ks & 1) + 4 * hi;
#pragma unroll
                for (int db = 0; db < 2; ++db) { const LAS bf16* vp = VT + (db * 32 + r32) * VTP + kbase; const v2u lo = *(const LAS v2u*)vp, hi4 = *(const LAS v2u*)(vp + 8);
                    pg8::u32x4 bw; bw.x = lo.x; bw.y = lo.y; bw.z = hi4.x; bw.w = hi4.y; o[db] = __builtin_amdgcn_mfma_f32_32x32x16_bf16(__builtin_bit_cast(bf16x8, bw), pa[ks], o[db], 0, 0, 0); } }
            { const float inv = __builtin_amdgcn_rcpf(sum); bf16* op = PROJ + (size_t)(q0 + kw0 + r32) * PP + C_CQ + hd * 64 + 4 * hi;
#pragma unroll
                for (int db = 0; db < 2; ++db)
#pragma unroll
                    for (int rg = 0; rg < 4; ++rg) { v2u w_; w_.x = pg8::cvt_pk_bf16(o[db][4 * rg] * inv, o[db][4 * rg + 1] * inv); w_.y = pg8::cvt_pk_bf16(o[db][4 * rg + 2] * inv, o[db][4 * rg + 3] * inv); *(GAS v2u*)(op + db * 32 + rg * 8) = w_; } }
        }
    }
    __syncthreads();
}

__device__ __forceinline__ float wave_max(float v) {
#pragma unroll
    for (int o = 1; o < 64; o <<= 1) v = fmaxf(v, __shfl_xor(v, o));
    return v;
}
__device__ __forceinline__ void fox_bounds_phase(const Frame& F, const bf16* PROJ, float* KN, float* QN) {
    const int gw = F.vcu * NWAVES + F.wave, NGW = F.G * NWAVES, q = F.lane & 7, rsub = F.lane >> 3;
    for (int it = gw; it < 64 * 128 + 64 * 32; it += NGW) {
        const bool isk = it < 64 * 128; const int i2 = isk ? it : it - 64 * 128; const int bh = isk ? (i2 >> 7) : (i2 >> 5), blk = isk ? (i2 & 127) : (i2 & 31), b = bh >> 3, hd = bh & 7;
        const int npass = isk ? 8 : 32; const size_t row0 = (size_t)b * SEQ + (isk ? blk * 64 : blk * 256); const bf16* base = PROJ + row0 * PP + (isk ? C_DK : C_DQ) + hd * 64 + q * 8; float mx = 0.f;
#pragma unroll 8
        for (int ps = 0; ps < npass; ++ps) { const v4u x = *(const GAS v4u*)(base + (size_t)(ps * 8 + rsub) * PP);
            float ss = (bflo(x.x) * bflo(x.x) + bfhi(x.x) * bfhi(x.x)) + (bflo(x.y) * bflo(x.y) + bfhi(x.y) * bfhi(x.y)) + (bflo(x.z) * bflo(x.z) + bfhi(x.z) * bfhi(x.z)) + (bflo(x.w) * bflo(x.w) + bfhi(x.w) * bfhi(x.w));
            ss += __shfl_xor(ss, 1); ss += __shfl_xor(ss, 2); ss += __shfl_xor(ss, 4);
            mx = fmaxf(mx, ss); }
        mx = wave_max(mx);
        if (F.lane == 0) (isk ? KN : QN)[i2] = sqrtf(mx) * 1.001f + 1e-3f;
    }
}
__device__ __forceinline__ void fox_cum_phase(const Frame& F, const float* LC, const float* TOT, float* CUMT) {
    const int gw = F.vcu * NWAVES + F.wave, NGW = F.G * NWAVES;
    for (int it = gw; it < 64 * 32; it += NGW) { const int bh = it >> 5, ck = it & 31, b = bh >> 3, hd = bh & 7;
        float tv = (F.lane < ck) ? TOT[(size_t)(b * 32 + F.lane) * 8 + hd] : 0.f; tv = wave_sum(tv);
#pragma unroll
        for (int q = 0; q < 4; ++q) { const int t = ck * 256 + q * 64 + F.lane; CUMT[(size_t)bh * SEQ + t] = LC[((size_t)b * SEQ + t) * 8 + hd] + tv; } }
}
__device__ __forceinline__ void fox_plan_phase(const Frame& F, const float* CUMT, const float* KN, const float* QN, int* TLO) {
    const int gw = F.vcu * NWAVES + F.wave, NGW = F.G * NWAVES;
    for (int it = gw; it < 64 * 32; it += NGW) { const int bh = it >> 5, qb = it & 31, NTf = 4 * qb + 4;
        const int t0 = F.lane, t1 = F.lane + 64; float kn = fmaxf(t0 < NTf ? KN[bh * 128 + t0] : 0.f, t1 < NTf ? KN[bh * 128 + t1] : 0.f); kn = wave_max(kn);
        const float bnd = QN[it] * kn + CUMT[(size_t)bh * SEQ + qb * 256];
        const bool d0 = (t0 < NTf) && (bnd - CUMT[(size_t)bh * SEQ + 64 * t0 + 63] < -160.0f), d1 = (t1 < NTf) && (bnd - CUMT[(size_t)bh * SEQ + 64 * t1 + 63] < -160.0f);
        int tlo = (__popcll(__ballot(d0)) + __popcll(__ballot(d1))) & ~1; tlo = tlo > NTf - 4 ? NTf - 4 : tlo;
        if (F.lane == 0) TLO[it] = tlo; }
}
__device__ __forceinline__ int attn_phase(const Frame& F, char* lds_generic, bf16* PROJ, const float* CUMT, const int* TLO, unsigned* qctr, int first = -1, int uoff = 0) {
    using attn_body::attn_unit;
    typedef __hip_bfloat16 hb;
    LAS float* ckl = (LAS float*)(F.lds + CKL_OFF);
    LAS int* sh = (LAS int*)(ckl + 8192 + 64);
    for (bool have = first >= 0;; have = false) {
        int tid = threadIdx.x; asm volatile("" : "+v"(tid));
        int tk = first;
        if (!have) {
            if (tid == 0) sh[0] = (int)__hip_atomic_fetch_add(qctr, 1u, RLX_AGENT);
            LDS_WAIT(); __syncthreads();
            tk = __builtin_amdgcn_readfirstlane(sh[0]); }
        const int u = tk - uoff;
        if (u >= 2048) { __syncthreads(); return tk; }
        {
            const int qb = 31 - (u >> 6), bh = u & 63, b = bh >> 3, hd = bh & 7, NTf = 4 * qb + 4;
            const int tlo = __builtin_amdgcn_readfirstlane(TLO[bh * 32 + qb]);
            const int nfill = qb * 256 + 256 - 64 * tlo; const float* cs = CUMT + (size_t)bh * SEQ + 64 * tlo;
            for (int i = tid; i < nfill; i += NWAVES * 64) ckl[i] = cs[i];
            LDS_WAIT(); __syncthreads();
            const size_t q0 = (size_t)b * SEQ + (size_t)qb * 256, k0 = (size_t)b * SEQ + (size_t)tlo * 64;
            attn_unit<8, 0>((const hb*)(PROJ + q0 * PP + C_DQ + hd * 64), (const hb*)(PROJ + k0 * PP + C_DK + hd * 64), (const hb*)(PROJ + k0 * PP + C_DV + hd * 64), (hb*)(PROJ + q0 * PP + C_DQ + hd * 64),
                            NTf - tlo, 0, ckl, qb * 256 - 64 * tlo, -INFINITY, 0.f, lds_generic);
        }
    }
}
__device__ __forceinline__ int attn_queue_next(const Frame& F, unsigned* qctr) {
    LAS int* sh = (LAS int*)((LAS float*)(F.lds + CKL_OFF) + 8192 + 64);
    __syncthreads();
    if (F.tid == 0) sh[0] = (int)__hip_atomic_fetch_add(qctr, 1u, RLX_AGENT);
    LDS_WAIT(); __syncthreads();
    const int u = __builtin_amdgcn_readfirstlane(sh[0]);
    __syncthreads();
    return u;
}

__device__ __forceinline__ void moe_build_phase(const Frame& F, unsigned char* ws) {
    LAS int* sb = (LAS int*)(F.lds + RING_OFF);
    const int* gcnt = (const int*)(ws + WS_CTL) + CW_MOECNT; const int* wgc = (const int*)(ws + WS_MOE + MOE_WGCNT);
    int* s2t = (int*)(ws + WS_MOE + MOE_S2T); float* sw = (float*)(ws + WS_MOE + MOE_SW); int* tile_e = (int*)(ws + WS_MOE + MOE_TILE_E); int* ntl = (int*)(ws + WS_MOE + MOE_NT);
    for (int c = blockIdx.x; c < M / 256; c += F.G) {
        if (F.tid < 16) sb[16 + F.tid] = __hip_atomic_load(gcnt + F.tid, RLX_AGENT);
        { const int ke = F.tid & 15, part = F.tid >> 4; int p = 0;
#pragma unroll
            for (int q = 0; q < 8; ++q) { const int c2 = part * 8 + q; if (c2 < c) p += wgc[c2 * 16 + ke]; }
            sb[1100 + F.tid] = p; }
        if (F.tid < 256) { const v4u r = *(const GAS v4u*)(ws + WS_ROUTE + ((size_t)c * 256 + F.tid) * 16); sb[64 + F.tid * 2] = (int)r.x; sb[64 + F.tid * 2 + 1] = (int)r.y; sb[576 + F.tid * 2] = (int)r.z; sb[576 + F.tid * 2 + 1] = (int)r.w; }
        LDS_WAIT(); __syncthreads();
        if (F.tid < 16) { int p = 0; for (int part = 0; part < 32; ++part) p += sb[1100 + part * 16 + F.tid]; sb[32 + F.tid] = p; }
        if (F.tid < 2) { int run = 0; for (int e = 0; e < 8; ++e) { sb[F.tid * 8 + e] = run; run += (sb[16 + F.tid * 8 + e] + 255) & ~255; } if (c == 0) ntl[F.tid] = run >> 8; }
        int e_[2] = {0, 0}, rk_[2] = {0, 0};
        if (F.tid < 256) {
#pragma unroll
            for (int k = 0; k < 2; ++k) { const int e = sb[64 + F.tid * 2 + k]; e_[k] = e;
#pragma unroll
                for (int e2 = 0; e2 < 8; ++e2) { const unsigned long long m = __ballot(e == e2); if (e == e2) rk_[k] = __popcll(m & ((1ull << F.lane) - 1ull)); if (F.lane == 0) sb[1700 + (k * 4 + F.wave) * 8 + e2] = __popcll(m); } }
        }
        LDS_WAIT(); __syncthreads();
        if (F.tid < 256) {
#pragma unroll
            for (int k = 0; k < 2; ++k) { const int e = e_[k], ke = k * 8 + e; int slot = sb[ke] + sb[32 + ke] + rk_[k]; for (int w = 0; w < F.wave; ++w) slot += sb[1700 + (k * 4 + w) * 8 + e];
                s2t[(size_t)k * SLOTS + slot] = c * 256 + F.tid; sw[(size_t)k * SLOTS + slot] = __int_as_float(sb[576 + F.tid * 2 + k]); }
        }
        if (c == 0) {
            for (int q = F.tid; q < 16 * 256; q += NWAVES * 64) { const int ke = q >> 8, i = q & 255, k = ke >> 3; const int tot = sb[16 + ke], pad = ((tot + 255) & ~255) - tot; if (i < pad) { s2t[(size_t)k * SLOTS + sb[ke] + tot + i] = -1; sw[(size_t)k * SLOTS + sb[ke] + tot + i] = 0.f; }
                const int nt = (tot + 255) >> 8; if (i < nt) tile_e[k * 512 + (sb[ke] >> 8) + i] = ke & 7; } }
        LDS_WAIT(); __syncthreads();
    }
}
__device__ __forceinline__ void moe_gather_phase(const Frame& F, unsigned char* ws, int k) {
    const int gw = F.vcu * NWAVES + F.wave, NGW = F.G * NWAVES;
    const int rows = ((const int*)(ws + WS_MOE + MOE_NT))[k] * 256; const int* s2t = (const int*)(ws + WS_MOE + MOE_S2T) + (size_t)k * SLOTS;
    for (int sl = gw; sl < rows; sl += NGW) { const int tok = s2t[sl]; v4u a = (v4u){0u, 0u, 0u, 0u}, b = a;
        if (tok >= 0) { const GAS v4u* src = (const GAS v4u*)(ws + WS_XN + (size_t)tok * DM * 2); a = src[F.lane]; b = src[64 + F.lane]; }
        GAS v4u* dst = (GAS v4u*)(ws + WS_XG + (size_t)sl * DM * 2); dst[F.lane] = a; dst[64 + F.lane] = b; }
}
__device__ __forceinline__ void final_norm_phase(const Frame& F, const bf16* h, float* out, const float* gain, const unsigned* tmo) {
    const float bad = (__hip_atomic_load(tmo, RLX_AGENT) != 0u) ? 1e15f : 1.0f;
    const int gw = F.vcu * NWAVES + F.wave, NGW = F.G * NWAVES;
    f32x4 g4[4];
#pragma unroll
    for (int j = 0; j < 4; ++j) g4[j] = ((const GAS f32x4*)gain)[F.lane + 64 * j];
    for (int row0 = gw; row0 < M; row0 += 2 * NGW) {
        v2u w[2][4];
#pragma unroll
        for (int q = 0; q < 2; ++q) { const GAS v2u* xr = (const GAS v2u*)(h + (size_t)(row0 + q * NGW) * DM) + F.lane;
#pragma unroll
            for (int j = 0; j < 4; ++j) w[q][j] = xr[64 * j]; }
#pragma unroll
        for (int q = 0; q < 2; ++q) { const int row = row0 + q * NGW; GAS f32x4* orow = (GAS f32x4*)(out + (size_t)row * DM) + F.lane; f32x4 v[4]; float s = 0.f;
#pragma unroll
            for (int j = 0; j < 4; ++j) { v[j] = (f32x4){bflo(w[q][j].x), bfhi(w[q][j].x), bflo(w[q][j].y), bfhi(w[q][j].y)}; s += (v[j].x * v[j].x + v[j].y * v[j].y) + (v[j].z * v[j].z + v[j].w * v[j].w); }
            const float rstd = 1.f / sqrtf(wave_sum(s) * (1.f / DM) + EPS);
#pragma unroll
            for (int j = 0; j < 4; ++j) orow[64 * j] = v[j] * (rstd * bad) * g4[j]; } }
}
constexpr int NPH = 28;
constexpr int PH_LAYER0 = 2;
constexpr int PH_FINAL = PH_LAYER0 + DEPTH * NPH, PH_TOTAL = PH_FINAL + 1;

typedef const __attribute__((address_space(4))) Args* CArgs;
__device__ __forceinline__ CArgs get_args() { CArgs p = (CArgs)__builtin_amdgcn_kernarg_segment_ptr(); asm volatile("" : "+s"(p)); return p; }
__device__ __forceinline__ Frame make_frame(LAS unsigned char* ldsp) {
    Frame F; int tid = threadIdx.x; asm volatile("" : "+v"(tid));
    F.lds = ldsp; F.tid = tid; F.lane = tid & 63; F.wave = __builtin_amdgcn_readfirstlane(tid >> 6);
    F.G = gridDim.x; { const int bx = blockIdx.x; F.vcu = (F.G % 8 == 0) ? (bx % 8) * (F.G / 8) + bx / 8 : bx; }
    return F;
}
__device__ __forceinline__ bool ph_in(int k) { CArgs a = get_args(); return a->ph_lo <= k && k < a->ph_hi; }
__device__ __forceinline__ void seam(int nextk, LAS unsigned char* ldsp) {
    CArgs a = get_args();
    if (a->ph_lo <= nextk && nextk < a->ph_hi) { XcdBarrier b; b.bar = (unsigned*)(a->ws + WS_CTL) + CW_BAR; b.x = xb_xcc_id(); b.st = (volatile LAS unsigned*)(ldsp + MISC_OFF) + 8; xcd_barrier(b); }
}

__global__ void __launch_bounds__(NWAVES * 64, 2) hybrid_fwd(Args args_unused) {
    extern __shared__ __attribute__((aligned(16))) unsigned char lds[];
    LAS unsigned char* const ldsp = (LAS unsigned char*)lds;
    for (int u = threadIdx.x; u < (LDS_BYTES - LDSCTL_OFF) / 4; u += NWAVES * 64) ((LAS unsigned*)(ldsp + LDSCTL_OFF))[u] = 0u;
    __syncthreads();
    { CArgs a = get_args(); if (a->ph_hi - a->ph_lo > 1) (void)xcd_barrier_post((unsigned*)(a->ws + WS_CTL) + CW_BAR, (volatile LAS unsigned*)(ldsp + MISC_OFF) + 8); }
#define IN(k) ph_in(k)
#ifdef MK_DUP_PHASE
#define REPS(k) (((k) == MK_DUP_PHASE) ? MK_DUP_N : 1)
#else
#define REPS(k) 1
#endif
#define SEAM(k) seam((k) + 1, ldsp)
#define SEAMN(nk) seam((nk), ldsp)
#define PH_BEGIN const Frame F = make_frame(ldsp); CArgs args = get_args(); unsigned char* ws = args->ws; bf16* H = (bf16*)(ws + WS_H); bf16* XN = (bf16*)(ws + WS_XN); bf16* PROJ = (bf16*)(ws + WS_PROJ); bf16* XC = (bf16*)(ws + WS_XC); \
                 LAS unsigned char* ring = ldsp + RING_OFF; const int bx = (int)blockIdx.x; (void)H; (void)XN; (void)PROJ; (void)XC; (void)ring; (void)bx; (void)F;

    if (IN(0)) { PH_BEGIN for (int rep_ = 0; rep_ < REPS(0); ++rep_) { p0_prologue(F, args); } __syncthreads(); }
#ifdef MK_EXTRA_BAR
    for (int xb_ = 0; xb_ < MK_EXTRA_BAR; ++xb_) seam(1, ldsp);
#endif
    for (int l = 0; l < DEPTH; ++l) {
        const int pb = PH_LAYER0 + l * NPH;
        if (IN(pb + 0)) { PH_BEGIN
            for (int rep_ = 0; rep_ < REPS(pb + 0); ++rep_)
            if (l == 0) norm_phase<1, true>(F, args->in[I_X], args->in[I_NORM_MIX] + (size_t)l * DM, XN, args->in[I_W_IN] + (size_t)l * DM * DIN + NPROJ, DIN, args->in[I_FOX_BF] + l * 8, ws);
            else norm_phase<1, false>(F, H, args->in[I_NORM_MIX] + (size_t)l * DM, XN, args->in[I_W_IN] + (size_t)l * DM * DIN + NPROJ, DIN, args->in[I_FOX_BF] + l * 8, ws);
            SEAM(pb + 0); }
        if (IN(pb + 1)) {
            PH_BEGIN
            pg8::Gemm g{XN, DM, (const bf16*)(ws + WS_WIN) + (size_t)l * NPROJ * DM, 0, DM}; pg8::StaticOrder S; S.init(M, NPROJ, F.G, bx);
            pg8::EpiProj E{PROJ, PP, attn_body::C2};
            for (int rep_ = 0; rep_ < REPS(pb + 1); ++rep_) { pg8::gemm_phase<pg8::EpiProj, pg8::StaticOrder, true>(ring, g, S, E); }
            SEAM(pb + 1);
        }
        if (IN(pb + 2)) {
            PH_BEGIN
            for (int rep_ = 0; rep_ < REPS(pb + 2); ++rep_) { conv_phase(F, PROJ, args->in[I_CONV_W] + (size_t)l * 4 * 512, args->in[I_CONV_B] + (size_t)l * 512, XC); }
            fox_bounds_phase(F, PROJ, (float*)(ws + WS_KN), (float*)(ws + WS_QN));
            fox_cum_phase(F, (const float*)(ws + WS_LC), (const float*)(ws + WS_TOT), (float*)(ws + WS_CUMT));
            sgu_phase(F, PROJ, (const bf16*)(ws + WS_WSGU) + (size_t)l * 4 * 128 * 128, args->in[I_SGU_G] + (size_t)l * 512, args->in[I_SGU_B] + (size_t)l * 512);
            SEAMN(pb + 4);
        }
        if (IN(pb + 4)) { PH_BEGIN fox_plan_phase(F, (const float*)(ws + WS_CUMT), (const float*)(ws + WS_KN), (const float*)(ws + WS_QN), (int*)(ws + WS_TLO));
            for (int rep_ = 0; rep_ < REPS(pb + 4); ++rep_) lru_gate_phase(F, XC, (const bf16*)(ws + WS_WLRU) + (size_t)l * 1024 * 128, PROJ, args->in[I_RG_BA] + (size_t)l * 512, args->in[I_RG_BX] + (size_t)l * 512, args->in[I_RG_LAMBDA] + (size_t)l * 512, (float*)(ws + WS_LA), (float*)(ws + WS_LH), (float*)(ws + WS_LA8), (float*)(ws + WS_LH8)); SEAMN(pb + 6); }
        if (IN(pb + 6)) { PH_BEGIN lru_pass2(F, PROJ, (const float*)(ws + WS_LA), (const float*)(ws + WS_LH), (const float*)(ws + WS_LA8), (const float*)(ws + WS_LH8));
            __syncthreads(); }
        if (IN(pb + 7)) { { PH_BEGIN swa_phase(F, PROJ, args->in[I_SWA_SINKS] + l * 8); }
            PH_BEGIN unsigned* qc_ = (unsigned*)(ws + WS_CTL) + CW_ATTQ + 64 * l; int ut_ = -1, uo_ = 0;
            if (l == 0) {
                pg8::Gemm g{(const bf16*)(ws + WS_MEMN), DM, (const bf16*)(ws + WS_WKV), (long)1024 * DM, DM}; pg8::EpiBf16 E{(bf16*)(ws + WS_KV), 1024};
                ut_ = attn_queue_next(F, qc_); uo_ = 64;
#pragma unroll 1
                while (ut_ < 64) { pg8::OneUnit S{ut_, 8}; pg8::gemm_phase<pg8::EpiBf16, pg8::OneUnit, true>(ring, g, S, E); ut_ = attn_queue_next(F, qc_); }
            }
            (void)attn_phase(F, (char*)lds + RING_OFF, PROJ, (const float*)(ws + WS_CUMT), (const int*)(ws + WS_TLO), qc_, ut_, uo_);
            SEAM(pb + 7); }
        if (IN(pb + 8)) {
            PH_BEGIN
            pg8::GBParams gp{XN, PROJ, PP, C_AU, C_BY, C_CQ, C_DQ, (const bf16*)(ws + WS_WG) + (size_t)l * 4 * DM * DM, (const bf16*)(ws + WS_WB) + (size_t)l * 4 * DM * DM};
            pg8::StaticOrder S; S.init(M, DM, F.G, bx);
            pg8::EpiGateBranch<0> E{PROJ + C_G, PROJ + C_MG, PP, args->in[I_B_GATE] + (size_t)l * 4 * DM};
            pg8::gemm_gb_phase<pg8::EpiGateBranch<0>>(ring, gp, S, E);
#ifdef MK_GB_VAR
            if (l == 0) { pg8::EpiGateBranch<MK_GB_VAR> E2{(bf16*)args->out, (bf16*)args->out + 1024, 2048, args->in[I_B_GATE] + (size_t)l * 4 * DM};
                pg8::gemm_gb_phase<pg8::EpiGateBranch<MK_GB_VAR>>(ring, gp, S, E2); }
#endif
            SEAMN(pb + 15);
        }
        if (IN(pb + 15)) {
            PH_BEGIN
            pg8::Gemm g{PROJ + C_MG, PP, (const bf16*)(ws + WS_WOUT) + (size_t)l * DM * DM, 0, DM}; pg8::StaticOrder S; S.init(M, DM, F.G, bx);
            if (l == 0) { pg8::EpiResid<true, true> E{args->in[I_X], H, DM, (float*)(ws + WS_SSQ)}; for (int rep_ = 0; rep_ < REPS(pb + 15); ++rep_) { pg8::gemm_phase<pg8::EpiResid<true, true>, pg8::StaticOrder, true>(ring, g, S, E); } }
            else { pg8::EpiResid<false, true> E{nullptr, H, DM, (float*)(ws + WS_SSQ)}; pg8::gemm_phase<pg8::EpiResid<false, true>, pg8::StaticOrder, true>(ring, g, S, E); }
            SEAMN(pb + 17);
        }
#ifndef MK_SKIP_CROSS
        if (IN(pb + 17)) {
            PH_BEGIN
            pg8::Gemm g{H, DM, (const bf16*)(ws + WS_WQ) + (size_t)l * 512 * DM, 0, DM}; pg8::StaticOrder S; S.init(M, 512, F.G, bx);
            pg8::EpiBf16Rs E{PROJ, 512, (const float*)(ws + WS_SSQ)};
            for (int rep_ = 0; rep_ < REPS(pb + 17); ++rep_) { pg8::gemm_phase<pg8::EpiBf16Rs, pg8::StaticOrder, true>(ring, g, S, E); }
            SEAM(pb + 17);
        }
        if (IN(pb + 18)) { PH_BEGIN for (int rep_ = 0; rep_ < REPS(pb + 18); ++rep_) { xattn_phase(F, PROJ, (const bf16*)(ws + WS_KV) + (size_t)l * 2048 * 1024, rep_ ? (bf16*)args->out : PROJ); } SEAM(pb + 18); }
        if (IN(pb + 19)) {
            PH_BEGIN
            pg8::Gemm g{PROJ, 512, (const bf16*)(ws + WS_WOC) + (size_t)l * DM * 512, 0, 512}; pg8::StaticOrder S; S.init(M, DM, F.G, bx);
            pg8::EpiResid<false, true> E{nullptr, H, DM, (float*)(ws + WS_SSQ)};
            pg8::gemm_phase<pg8::EpiResid<false, true>, pg8::StaticOrder, true>(ring, g, S, E);
            SEAMN((l & 1) == 0 ? pb + 21 : pb + 20);
        }
#endif
        if ((l & 1) == 0) {
#ifndef MK_SKIP_FFN0
            if (IN(pb + 21)) {
                PH_BEGIN
                pg8::Gemm g{H, DM, (const bf16*)(ws + WS_W13) + (size_t)(l >> 1) * 2 * DFF * DM, 0, DM}; pg8::StaticOrder S; S.init(M, 2 * DFF, F.G, bx);
                pg8::EpiSwiglu<true> E{(bf16*)(ws + WS_ACT), DFF, (const float*)(ws + WS_SSQ)};
                for (int rep_ = 0; rep_ < REPS(pb + 21); ++rep_) { pg8::gemm_phase<pg8::EpiSwiglu<true>, pg8::StaticOrder, true>(ring, g, S, E); }
                SEAM(pb + 21);
            }
            if (IN(pb + 22)) {
                PH_BEGIN
                pg8::Gemm g{(const bf16*)(ws + WS_ACT), DFF, (const bf16*)(ws + WS_W2) + (size_t)(l >> 1) * DM * DFF, 0, DFF}; pg8::StaticOrder S; S.init(M, DM, F.G, bx);
                pg8::EpiResid<false> E{nullptr, H, DM, nullptr};
                pg8::gemm_phase<pg8::EpiResid<false>, pg8::StaticOrder, true>(ring, g, S, E);
#ifdef MK_W2_PROBE
                { pg8::EpiBf16 E2{(bf16*)args->out, DM}; pg8::gemm_phase<pg8::EpiBf16, pg8::StaticOrder, true>(ring, g, S, E2); }
#endif
                SEAMN(pb + NPH);
            }
#endif
        } else {
#ifndef MK_SKIP_FFN1
            if (IN(pb + 20)) { PH_BEGIN norm_phase<2, false>(F, H, args->in[I_NORM_FFN] + (size_t)l * DM, XN, args->in[I_ROUTER_W] + (size_t)(l >> 1) * DM * NE, NE, args->in[I_ROUTER_B] + (l >> 1) * NE, ws); for (int rep_ = 0; rep_ < REPS(pb + 20); ++rep_) { moe_convert_phase(F, args); } SEAM(pb + 20); }
            if (IN(pb + 21)) { PH_BEGIN for (int rep_ = 0; rep_ < REPS(pb + 21); ++rep_) { moe_build_phase(F, ws); } SEAM(pb + 21); }
            for (int k = 0; k < 2; ++k) {
                const int pk = pb + 22 + 3 * k;
                if (IN(pk + 1)) {
                    PH_BEGIN
                    const int ntl = ((const int*)(ws + WS_MOE + MOE_NT))[k]; const int* te = (const int*)(ws + WS_MOE + MOE_TILE_E) + k * 512;
                    const int ntl0 = ((const int*)(ws + WS_MOE + MOE_NT))[0]; const int rot = (k == 1) ? ((((ntl0 * 4) % F.G) + 7) & ~7) % F.G : 0;
                    pg8::Gemm g{XN, DM, (const bf16*)(ws + WS_MW13) + (size_t)(l >> 1) * NE * 2 * DFF * DM, (long)2 * DFF * DM, DM}; pg8::TableOrder S; S.init(ntl, 2 * DFF, F.G, (bx + F.G - rot) % F.G, te);
                    pg8::EpiSwiglu<false> E{(bf16*)(ws + WS_ACT), DFF, nullptr, (k == 1) ? (unsigned*)(ws + WS_CTL) + CW_G2DONE : nullptr, ntl0, (unsigned*)(ws + WS_CTL) + CW_BAR + XB_TMO};
                    pg8::gemm_phase_ga<pg8::EpiSwiglu<false>, pg8::TableOrder, true>(ring, g, S, E, (const int*)(ws + WS_MOE + MOE_S2T) + (size_t)k * SLOTS);
                    SEAM(pk + 1);
                }
                if (IN(pk + 2)) {
                    PH_BEGIN
                    const int ntl = ((const int*)(ws + WS_MOE + MOE_NT))[k]; const int* te = (const int*)(ws + WS_MOE + MOE_TILE_E) + k * 512;
                    pg8::Gemm g{(const bf16*)(ws + WS_ACT), DFF, (const bf16*)(ws + WS_MW2) + (size_t)(l >> 1) * NE * DM * DFF, (long)DM * DFF, DFF}; pg8::TableOrder S; S.init(ntl, DM, F.G, bx, te);
                    pg8::EpiMoeOut E{H, (const int*)(ws + WS_MOE + MOE_S2T) + (size_t)k * SLOTS, (const float*)(ws + WS_MOE + MOE_SW) + (size_t)k * SLOTS, (k == 0) ? (unsigned*)(ws + WS_CTL) + CW_G2DONE : nullptr};
                    pg8::gemm_phase<pg8::EpiMoeOut, pg8::TableOrder, true>(ring, g, S, E);
                    if (k == 0) __syncthreads(); else SEAM(pk + 2);
                }
            }
#endif
        }
    }
    if (IN(PH_FINAL)) { PH_BEGIN for (int rep_ = 0; rep_ < REPS(PH_FINAL); ++rep_) { final_norm_phase(F, H, args->out, args->in[I_NORM_FINAL], (const unsigned*)(ws + WS_CTL) + CW_BAR + XB_TMO); } }
#undef IN
#undef SEAM
#undef SEAMN
#undef PH_BEGIN
}

#ifdef MK_DUMP_COL
__global__ void dump_cols(const unsigned short* PROJ, float* out) {
    const size_t i = (size_t)blockIdx.x * blockDim.x + threadIdx.x; const size_t t = i >> 10; const int c = (int)(i & 1023);
    out[i] = __uint_as_float(((unsigned)PROJ[t * PP + MK_DUMP_COL + c]) << 16);
}
#endif
#ifdef MK_CHECK
static void dbg_launch(const Args& a, int stage, int l, float* d_out, void* d_ws, hipStream_t stream);
#endif
extern "C" void kernel_launch(void* const* d_in, const int* in_sizes, int n_in, void* d_out, int out_size, void* d_ws, size_t ws_size, hipStream_t stream) {
    static int grid = 0;
    if (grid == 0) {
        if (n_in != 33 || out_size != M * DM || ws_size < WS_END) { fprintf(stderr, "kernel_launch: unexpected shapes (n_in %d, out %d, ws %zu); nothing launched\n", n_in, out_size, ws_size); grid = -1; return; }
        { const long exp_[33] = {(long)M * DM, (long)BATCH * MEMLEN * DM, 2L * DM, 2L * DM * DIN, 2L * 512, 2L * 4 * 128 * 128, 2L * 4 * 128, 2L * 4 * 512, 2L * 512, 2L * 4 * 128 * 128, 2L * 512, 2L * 4 * 128 * 128, 2L * 512, 2L * 512, 2L * 8, 2L * 8,
              2L * 4 * 512 * DM, 2L * 4 * DM * DM, 2L * 4 * DM, 2L * DM * DM, 2L * DM, 2L * DM, 2L * DM * 512, 2L * DM * 1024, 2L * 512 * DM, 2L * DM, 1L * DM * 2 * DFF, 1L * DFF * DM, 1L * DM * NE, 1L * NE, 8L * DM * 2 * DFF, 8L * DFF * DM, (long)DM};
          for (int i = 0; i < 33; ++i) if ((long)in_sizes[i] != exp_[i]) { fprintf(stderr, "kernel_launch: input %d has %d elements, expected %ld; nothing launched\n", i, in_sizes[i], exp_[i]); grid = -1; return; } }
        int dev = 0, cus = 0, per_cu = 0;
        if (hipGetDevice(&dev) != hipSuccess || hipDeviceGetAttribute(&cus, hipDeviceAttributeMultiprocessorCount, dev) != hipSuccess) { grid = -1; return; }
        if (hipFuncSetAttribute((const void*)hybrid_fwd, hipFuncAttributeMaxDynamicSharedMemorySize, LDS_BYTES) != hipSuccess) { grid = -1; return; }
        if (hipOccupancyMaxActiveBlocksPerMultiprocessor(&per_cu, (const void*)hybrid_fwd, NWAVES * 64, LDS_BYTES) != hipSuccess || per_cu < 1) { fprintf(stderr, "kernel_launch: occupancy query reports %d\n", per_cu); }
        (void)hipGetLastError();
        grid = cus;
    }
    if (grid < 0) return;
    (void)hipMemsetAsync((char*)d_ws + WS_CTL, 0, CTL_ZERO_BYTES, stream);
    Args a{};
    for (int i = 0; i < 33; ++i) a.in[i] = (const float*)d_in[i];
    a.out = (float*)d_out; a.ws = (unsigned char*)d_ws;
#ifndef MK_SPLIT
#ifdef MK_PH_HI
    a.ph_lo = 0; a.ph_hi = MK_PH_HI;
    hipLaunchKernelGGL(hybrid_fwd, dim3(grid), dim3(NWAVES * 64), LDS_BYTES, stream, a);
#ifdef MK_CHECK
    dbg_launch(a, MK_CHECK, 0, (float*)d_out, d_ws, stream);
    return;
#endif
#ifdef MK_DUMP_COL
    hipLaunchKernelGGL(dump_cols, dim3(M * DM / 256), dim3(256), 0, stream, (const unsigned short*)((unsigned char*)d_ws + WS_PROJ), (float*)d_out);
    return;
#endif
#ifdef MK_NO_FINAL
    return;
#endif
    a.ph_lo = PH_FINAL; a.ph_hi = PH_FINAL + 1;
#else
    a.ph_lo = 0; a.ph_hi = PH_TOTAL;
#endif
    hipLaunchKernelGGL(hybrid_fwd, dim3(grid), dim3(NWAVES * 64), LDS_BYTES, stream, a);
#else
    for (int p = 0; p < PH_TOTAL; ++p) { a.ph_lo = p; a.ph_hi = p + 1; hipLaunchKernelGGL(hybrid_fwd, dim3(grid), dim3(NWAVES * 64), LDS_BYTES, stream, a); }
#endif
}
```

```cpp
#include <hip/hip_runtime.h>
#include <cstdio>
#include <cstdint>
namespace pg8 {
#define PG8_LAS __attribute__((address_space(3)))
typedef unsigned short bf16_t;
typedef short bf16x8 __attribute__((ext_vector_type(8)));
typedef float f32x4 __attribute__((ext_vector_type(4)));
typedef float f32x2 __attribute__((ext_vector_type(2)));
typedef unsigned u32x4 __attribute__((ext_vector_type(4)));
typedef unsigned u32x2 __attribute__((ext_vector_type(2)));
constexpr int BM = 256, BK = 64, HALF = 128, HTB = HALF * BK * 2  , STAGE_BYTES = 8 * HTB, NXCD = 8, WGM = 8;

__host__ __device__ __forceinline__ int lds_byte(int r, int c) { const int st = (r >> 4) * 2 + (c >> 5), rr = r & 15, cc = c & 31, ob = rr * 64 + cc * 2; return st * 1024 + (ob ^ (((ob >> 9) & 1) << 5)); }
__host__ __device__ __forceinline__ void stage_rc(int b, int& R, int& C) { const int st = b / 1024, sb = b % 1024, swz = sb ^ (((sb >> 9) & 1) << 5); R = (st >> 1) * 16 + swz / 64; C = (st & 1) * 32 + (swz % 64) / 2; }
__host__ __device__ __forceinline__ int perm32(int rho) { const int n = rho >> 4, i = rho & 15; return 8 * (i >> 2) + 4 * n + (i & 3); }

struct Unit { int pm, pn, e; };
template <class E, class = void> struct zeroes_of { static constexpr bool value = false; };
template <class E> struct zeroes_of<E, decltype((void)E::ZEROES)> { static constexpr bool value = E::ZEROES; };
struct Gemm { const bf16_t* A; int lda; const bf16_t* Bt; long bes; int K; };

struct StaticOrder {
    int nM, nN, nwg, G, c, ediv;
    __device__ __forceinline__ void init(int M, int N, int G_, int c_, int ediv_ = 0) { nM = M / BM; nN = N / BM; nwg = nM * nN; G = G_; c = c_; ediv = ediv_; }
    __device__ __forceinline__ bool next(int i, Unit& u) const {
        const long L = (long)i * G + c; if (L >= nwg) return false;
        int wgid = (int)L; { const int q = nwg / NXCD, r = nwg % NXCD, xcd = wgid % NXCD, off = wgid / NXCD; wgid = (xcd < r ? xcd * (q + 1) : r * (q + 1) + (xcd - r) * q) + off; }
        const int nig = WGM * nN, gid = wgid / nig, fm = gid * WGM, gsz = (nM - fm) < WGM ? (nM - fm) : WGM;
        u.pm = fm + ((wgid % nig) % gsz); u.pn = (wgid % nig) / gsz; u.e = ediv ? u.pm / ediv : 0; return true;
    }
};
struct OneUnit {
    int idx, ediv;
    __device__ __forceinline__ bool next(int i, Unit& u) const { if (i != 0) return false; u.pn = idx & 3; u.pm = idx >> 2; u.e = ediv ? u.pm / ediv : 0; return true; }
};
struct TableOrder {
    int nM, nN, nwg, G, c; const int* etab;
    __device__ __forceinline__ void init(int nM_, int N, int G_, int c_, const int* etab_) { nM = nM_; nN = N / BM; nwg = nM * nN; G = G_; c = c_; etab = etab_; }
    __device__ __forceinline__ bool next(int i, Unit& u) const {
        const long L = (long)i * G + c; if (L >= nwg) return false;
        int wgid = (int)L; { const int q = nwg / NXCD, r = nwg % NXCD, xcd = wgid % NXCD, off = wgid / NXCD; wgid = (xcd < r ? xcd * (q + 1) : r * (q + 1) + (xcd - r) * q) + off; }
        const int nig = WGM * nN, gid = wgid / nig, fm = gid * WGM, gsz = (nM - fm) < WGM ? (nM - fm) : WGM;
        u.pm = fm + ((wgid % nig) % gsz); u.pn = (wgid % nig) / gsz; u.e = __builtin_amdgcn_readfirstlane(etab[u.pm]); return true;
    }
};

typedef float f32x2_cv __attribute__((ext_vector_type(2))); typedef __bf16 bf16x2_cv __attribute__((ext_vector_type(2)));
__device__ __forceinline__ unsigned cvt_pk_bf16(float lo, float hi) { const f32x2_cv v = {lo, hi}; const bf16x2_cv b = __builtin_convertvector(v, bf16x2_cv); return __builtin_bit_cast(unsigned, b); }
__device__ __forceinline__ float bf_lo(unsigned w) { return __uint_as_float(w << 16); }
__device__ __forceinline__ float bf_hi(unsigned w) { return __uint_as_float(w & 0xffff0000u); }
__device__ __forceinline__ float fast_sigmoid(float x) { return __builtin_amdgcn_rcpf(1.0f + __builtin_amdgcn_exp2f(-1.4426950408889634f * x)); }
__device__ __forceinline__ float gelu_tanh(float x) { const float u = x * (1.0f + 0.044715f * x * x); return x * __builtin_amdgcn_rcpf(1.0f + __builtin_amdgcn_exp2f(-2.302208198f * u)); }
__device__ __forceinline__ u32x4 pack8(const f32x4& v0, const f32x4& v1) { u32x4 w; w.x = cvt_pk_bf16(v0[0], v0[1]); w.y = cvt_pk_bf16(v0[2], v0[3]); w.z = cvt_pk_bf16(v1[0], v1[1]); w.w = cvt_pk_bf16(v1[2], v1[3]); return w; }

template <class Epi, class Sched, bool ALIGN_EPI>
__device__ __forceinline__ void gemm_phase(PG8_LAS unsigned char* lds, const Gemm g, const Sched& S, const Epi& E) {
    int tid_ = threadIdx.x; asm volatile("" : "+v"(tid_));
    const int tid = tid_, wid = __builtin_amdgcn_readfirstlane(tid >> 6), lane = tid & 63, wr = wid >> 2, wc = wid & 3, fr = lane & 15, fq = lane >> 4;
    const int K = g.K, nt = K / BK, lda = g.lda;
    unsigned voffA[2], voffB[2];
#pragma unroll
    for (int i = 0; i < 2; ++i) { int R, C; stage_rc(tid * 16 + i * 8192, R, C); const int Rb = (R & ~31) + perm32(R & 31);
        voffA[i] = (unsigned)(R * lda + C) * 2u; voffB[i] = (unsigned)(Rb * K + C) * 2u; }
    const size_t kstep = (size_t)(BK * 2);
    const size_t hstepA = (size_t)HALF * lda * 2, hstepB = (size_t)HALF * K * 2;
    const size_t tstepA = 2 * hstepA, tstepB = 2 * hstepB;
    const size_t estepB = (size_t)g.bes * 2;
    const unsigned ldsw = (unsigned)wid * 1024u;
    const int aoff = lds_byte(wr * 64 + fr, fq * 8), boff = lds_byte(wc * 32 + fr, fq * 8);
#define PG8_SA(b, h) (((b) * 2 + (h)) * HTB)
#define PG8_SB(b, h) ((4 + (b) * 2 + (h)) * HTB)
#define PG8_STAGE(bufoff, gbase, voff) do { _Pragma("unroll") for (int _i = 0; _i < 2; ++_i) \
        __builtin_amdgcn_global_load_lds((const unsigned*)((const char*)(gbase) + (voff)[_i]), (PG8_LAS unsigned*)(lds + (bufoff) + ldsw + _i * 8192), 16, 0, 0); } while (0)
#define PG8_LDA(dst, b, h) do { _Pragma("unroll") for (int m = 0; m < 4; ++m) _Pragma("unroll") for (int k = 0; k < 2; ++k) dst[m][k] = *(const PG8_LAS bf16x8*)(lds + PG8_SA(b, h) + aoff + m * 2048 + k * 1024); } while (0)
#define PG8_LDB(dst, b, h) do { _Pragma("unroll") for (int n = 0; n < 2; ++n) _Pragma("unroll") for (int k = 0; k < 2; ++k) dst[n][k] = *(const PG8_LAS bf16x8*)(lds + PG8_SB(b, h) + boff + n * 2048 + k * 1024); } while (0)
#define PG8_MMA(ai, bj, At, Bt) do { __builtin_amdgcn_s_setprio(1); _Pragma("unroll") for (int m = 0; m < 4; ++m) _Pragma("unroll") for (int n = 0; n < 2; ++n) _Pragma("unroll") for (int k = 0; k < 2; ++k) \
        acc[ai][bj][m][n] = __builtin_amdgcn_mfma_f32_16x16x32_bf16(Bt[n][k], At[m][k], acc[ai][bj][m][n], 0, 0, 0); __builtin_amdgcn_s_setprio(0); } while (0)
#define PG8_WAIT_V(n) asm volatile("s_waitcnt vmcnt(" #n ")" ::: "memory")
#define PG8_WAIT_L(n) asm volatile("s_waitcnt lgkmcnt(" #n ")" ::: "memory")
#define PG8_BAR __builtin_amdgcn_s_barrier()
#define PG8_SCHED __builtin_amdgcn_sched_barrier(0)
    Unit cur, nxt; int ui = 0;
    if (!S.next(0, cur)) return;
    f32x4 acc[2][2][4][2];
#pragma unroll
    for (int a = 0; a < 2; ++a)
#pragma unroll
        for (int b = 0; b < 2; ++b)
#pragma unroll
            for (int m = 0; m < 4; ++m)
#pragma unroll
                for (int n = 0; n < 2; ++n) acc[a][b][m][n] = (f32x4){0.f, 0.f, 0.f, 0.f};
    bf16x8 At[4][2], B0[2][2], B1[2][2];
    const char* cA = (const char*)g.A + (size_t)cur.pm * tstepA; const char* cB = (const char*)g.Bt + (size_t)cur.e * estepB + (size_t)cur.pn * tstepB;
    PG8_STAGE(PG8_SB(0, 0), cB, voffB); PG8_STAGE(PG8_SB(0, 1), cB + hstepB, voffB); PG8_STAGE(PG8_SA(0, 0), cA, voffA); PG8_STAGE(PG8_SA(0, 1), cA + hstepA, voffA);
    if (wr == 1) PG8_BAR;
    PG8_WAIT_V(2); PG8_BAR;
    PG8_STAGE(PG8_SB(1, 0), cB + kstep, voffB); PG8_STAGE(PG8_SA(1, 0), cA + kstep, voffA); PG8_STAGE(PG8_SB(1, 1), cB + hstepB + kstep, voffB);
    PG8_WAIT_V(6); PG8_BAR;
    for (;;) {
        const bool has_next = S.next(ui + 1, nxt);
        const char* nA = has_next ? (const char*)g.A + (size_t)nxt.pm * tstepA : cA; const char* nB = has_next ? (const char*)g.Bt + (size_t)nxt.e * estepB + (size_t)nxt.pn * tstepB : cB;
        for (int t = 0; t < nt; t += 2) {
            const bool last = (t == nt - 2);
            const char* a1 = cA + (size_t)(t + 1) * kstep;
            const char* a2 = last ? nA : cA + (size_t)(t + 2) * kstep; const char* b2 = last ? nB : cB + (size_t)(t + 2) * kstep;
            const char* a3 = a2 + kstep; const char* b3 = b2 + kstep;
            PG8_LDB(B0, 0, 0); PG8_LDB(B1, 0, 1); PG8_SCHED; PG8_LDA(At, 0, 0); PG8_STAGE(PG8_SA(1, 1), a1 + hstepA, voffA);
            PG8_WAIT_V(8); PG8_WAIT_L(0); PG8_BAR; PG8_MMA(0, 0, At, B0); PG8_MMA(0, 1, At, B1); PG8_BAR; PG8_SCHED;
            PG8_LDA(At, 0, 1); PG8_STAGE(PG8_SB(0, 0), b2, voffB); PG8_STAGE(PG8_SB(0, 1), b2 + hstepB, voffB); PG8_STAGE(PG8_SA(0, 0), a2, voffA);
            PG8_WAIT_V(8); PG8_WAIT_L(0); PG8_BAR; PG8_MMA(1, 0, At, B0); PG8_MMA(1, 1, At, B1); PG8_BAR; PG8_SCHED;
            PG8_LDB(B0, 1, 0); PG8_LDB(B1, 1, 1); PG8_SCHED; PG8_LDA(At, 1, 0); PG8_STAGE(PG8_SA(0, 1), a2 + hstepA, voffA);
            PG8_WAIT_V(8); PG8_WAIT_L(0); PG8_BAR; PG8_MMA(0, 0, At, B0); PG8_MMA(0, 1, At, B1); PG8_BAR; PG8_SCHED;
            PG8_LDA(At, 1, 1); PG8_STAGE(PG8_SB(1, 0), b3, voffB); PG8_STAGE(PG8_SB(1, 1), b3 + hstepB, voffB); PG8_STAGE(PG8_SA(1, 0), a3, voffA);
            PG8_WAIT_V(8); PG8_WAIT_L(0); PG8_BAR; PG8_MMA(1, 0, At, B0); PG8_MMA(1, 1, At, B1); PG8_BAR; PG8_SCHED;
        }
        if constexpr (ALIGN_EPI) { if (wr == 0) PG8_BAR; }
        E(acc, cur, wr, wc, fr, fq);
        if (!has_next) break;
        if constexpr (!zeroes_of<Epi>::value) {
#pragma unroll
        for (int a = 0; a < 2; ++a)
#pragma unroll
            for (int b = 0; b < 2; ++b)
#pragma unroll
                for (int m = 0; m < 4; ++m)
#pragma unroll
                    for (int n = 0; n < 2; ++n) acc[a][b][m][n] = (f32x4){0.f, 0.f, 0.f, 0.f};
        }
        cur = nxt; cA = nA; cB = nB; ++ui;
        if constexpr (ALIGN_EPI) { if (wr == 1) PG8_BAR; }
    }
    PG8_WAIT_V(0);
    if constexpr (!ALIGN_EPI) { if (wr == 0) PG8_BAR; }
    PG8_BAR;
#undef PG8_SA
#undef PG8_SB
#undef PG8_STAGE
#undef PG8_LDA
#undef PG8_LDB
#undef PG8_MMA
#undef PG8_WAIT_V
#undef PG8_WAIT_L
#undef PG8_BAR
#undef PG8_SCHED
}

template <class Epi, class Sched, bool ALIGN_EPI>
__device__ __forceinline__ void gemm_phase_ga(PG8_LAS unsigned char* lds, const Gemm g, const Sched& S, const Epi& E, const int* rowtab) {
    int tid_ = threadIdx.x; asm volatile("" : "+v"(tid_));
    const int tid = tid_, wid = __builtin_amdgcn_readfirstlane(tid >> 6), lane = tid & 63, wr = wid >> 2, wc = wid & 3, fr = lane & 15, fq = lane >> 4;
    const int K = g.K, nt = K / BK, lda = g.lda;
    unsigned voffB[2], vc[2][2], vn[2][2]; int RA[2], CA[2];
#pragma unroll
    for (int i = 0; i < 2; ++i) { int R, C; stage_rc(tid * 16 + i * 8192, R, C); const int Rb = (R & ~31) + perm32(R & 31);
        RA[i] = R; CA[i] = C; voffB[i] = (unsigned)(Rb * K + C) * 2u; }
#define PG8_ROWS(dst, pm_) do { const int* rt_ = rowtab + (pm_) * BM; const int t00_ = rt_[RA[0]], t01_ = rt_[RA[1]], t10_ = rt_[HALF + RA[0]], t11_ = rt_[HALF + RA[1]];     \
        dst[0][0] = (unsigned)((t00_ < 0 ? 0 : t00_) * lda + CA[0]) * 2u; dst[0][1] = (unsigned)((t01_ < 0 ? 0 : t01_) * lda + CA[1]) * 2u; dst[1][0] = (unsigned)((t10_ < 0 ? 0 : t10_) * lda + CA[0]) * 2u; dst[1][1] = (unsigned)((t11_ < 0 ? 0 : t11_) * lda + CA[1]) * 2u; } while (0)
#define PG8_SELV(dst, h_) unsigned dst[2]; dst[0] = last ? vn[h_][0] : vc[h_][0]; dst[1] = last ? vn[h_][1] : vc[h_][1]
    const size_t kstep = (size_t)(BK * 2);
    const size_t hstepA = (size_t)HALF * lda * 2, hstepB = (size_t)HALF * K * 2;
    const size_t tstepA = 2 * hstepA, tstepB = 2 * hstepB;
    const size_t estepB = (size_t)g.bes * 2;
    const unsigned ldsw = (unsigned)wid * 1024u;
    const int aoff = lds_byte(wr * 64 + fr, fq * 8), boff = lds_byte(wc * 32 + fr, fq * 8);
#define PG8_SA(b, h) (((b) * 2 + (h)) * HTB)
#define PG8_SB(b, h) ((4 + (b) * 2 + (h)) * HTB)
#define PG8_STAGE(bufoff, gbase, voff) do { _Pragma("unroll") for (int _i = 0; _i < 2; ++_i) \
        __builtin_amdgcn_global_load_lds((const unsigned*)((const char*)(gbase) + (voff)[_i]), (PG8_LAS unsigned*)(lds + (bufoff) + ldsw + _i * 8192), 16, 0, 0); } while (0)
#define PG8_LDA(dst, b, h) do { _Pragma("unroll") for (int m = 0; m < 4; ++m) _Pragma("unroll") for (int k = 0; k < 2; ++k) dst[m][k] = *(const PG8_LAS bf16x8*)(lds + PG8_SA(b, h) + aoff + m * 2048 + k * 1024); } while (0)
#define PG8_LDB(dst, b, h) do { _Pragma("unroll") for (int n = 0; n < 2; ++n) _Pragma("unroll") for (int k = 0; k < 2; ++k) dst[n][k] = *(const PG8_LAS bf16x8*)(lds + PG8_SB(b, h) + boff + n * 2048 + k * 1024); } while (0)
#define PG8_MMA(ai, bj, At, Bt) do { __builtin_amdgcn_s_setprio(1); _Pragma("unroll") for (int m = 0; m < 4; ++m) _Pragma("unroll") for (int n = 0; n < 2; ++n) _Pragma("unroll") for (int k = 0; k < 2; ++k) \
        acc[ai][bj][m][n] = __builtin_amdgcn_mfma_f32_16x16x32_bf16(Bt[n][k], At[m][k], acc[ai][bj][m][n], 0, 0, 0); __builtin_amdgcn_s_setprio(0); } while (0)
#define PG8_WAIT_V(n) asm volatile("s_waitcnt vmcnt(" #n ")" ::: "memory")
#define PG8_WAIT_L(n) asm volatile("s_waitcnt lgkmcnt(" #n ")" ::: "memory")
#define PG8_BAR __builtin_amdgcn_s_barrier()
#define PG8_SCHED __builtin_amdgcn_sched_barrier(0)
    Unit cur, nxt; int ui = 0;
    if (!S.next(0, cur)) return;
    f32x4 acc[2][2][4][2];
#pragma unroll
    for (int a = 0; a < 2; ++a)
#pragma unroll
        for (int b = 0; b < 2; ++b)
#pragma unroll
            for (int m = 0; m < 4; ++m)
#pragma unroll
                for (int n = 0; n < 2; ++n) acc[a][b][m][n] = (f32x4){0.f, 0.f, 0.f, 0.f};
    bf16x8 At[4][2], B0[2][2], B1[2][2];
    const char* const cA = (const char*)g.A; const char* cB = (const char*)g.Bt + (size_t)cur.e * estepB + (size_t)cur.pn * tstepB;
    PG8_ROWS(vc, cur.pm);
    PG8_STAGE(PG8_SB(0, 0), cB, voffB); PG8_STAGE(PG8_SB(0, 1), cB + hstepB, voffB); PG8_STAGE(PG8_SA(0, 0), cA, vc[0]); PG8_STAGE(PG8_SA(0, 1), cA, vc[1]);
    if (wr == 1) PG8_BAR;
    PG8_WAIT_V(2); PG8_BAR;
    PG8_STAGE(PG8_SB(1, 0), cB + kstep, voffB); PG8_STAGE(PG8_SA(1, 0), cA + kstep, vc[0]); PG8_STAGE(PG8_SB(1, 1), cB + hstepB + kstep, voffB);
    PG8_WAIT_V(6); PG8_BAR;
    for (;;) {
        const bool has_next = S.next(ui + 1, nxt);
        const char* nB = has_next ? (const char*)g.Bt + (size_t)nxt.e * estepB + (size_t)nxt.pn * tstepB : cB;
        { const int npm = has_next ? nxt.pm : cur.pm; PG8_ROWS(vn, npm); }
        const unsigned seen_ = E.peek(cur);
        for (int t = 0; t < nt; t += 2) {
            const bool last = (t == nt - 2);
            const char* a1 = cA + (size_t)(t + 1) * kstep;
            const char* a2 = last ? cA : cA + (size_t)(t + 2) * kstep; const char* b2 = last ? nB : cB + (size_t)(t + 2) * kstep;
            PG8_SELV(v0, 0); PG8_SELV(v1, 1);
            const char* a3 = a2 + kstep; const char* b3 = b2 + kstep;
            PG8_LDB(B0, 0, 0); PG8_LDB(B1, 0, 1); PG8_SCHED; PG8_LDA(At, 0, 0); PG8_STAGE(PG8_SA(1, 1), a1, vc[1]);
            PG8_WAIT_V(8); PG8_WAIT_L(0); PG8_BAR; PG8_MMA(0, 0, At, B0); PG8_MMA(0, 1, At, B1); PG8_BAR; PG8_SCHED;
            PG8_LDA(At, 0, 1); PG8_STAGE(PG8_SB(0, 0), b2, voffB); PG8_STAGE(PG8_SB(0, 1), b2 + hstepB, voffB); PG8_STAGE(PG8_SA(0, 0), a2, v0);
            PG8_WAIT_V(8); PG8_WAIT_L(0); PG8_BAR; PG8_MMA(1, 0, At, B0); PG8_MMA(1, 1, At, B1); PG8_BAR; PG8_SCHED;
            PG8_LDB(B0, 1, 0); PG8_LDB(B1, 1, 1); PG8_SCHED; PG8_LDA(At, 1, 0); PG8_STAGE(PG8_SA(0, 1), a2, v1);
            PG8_WAIT_V(8); PG8_WAIT_L(0); PG8_BAR; PG8_MMA(0, 0, At, B0); PG8_MMA(0, 1, At, B1); PG8_BAR; PG8_SCHED;
            PG8_LDA(At, 1, 1); PG8_STAGE(PG8_SB(1, 0), b3, voffB); PG8_STAGE(PG8_SB(1, 1), b3 + hstepB, voffB); PG8_STAGE(PG8_SA(1, 0), a3, v0);
            PG8_WAIT_V(8); PG8_WAIT_L(0); PG8_BAR; PG8_MMA(1, 0, At, B0); PG8_MMA(1, 1, At, B1); PG8_BAR; PG8_SCHED;
        }
        if constexpr (ALIGN_EPI) { if (wr == 0) PG8_BAR; }
        E(acc, cur, wr, wc, fr, fq, seen_);
        if (!has_next) break;
        if constexpr (!zeroes_of<Epi>::value) {
#pragma unroll
        for (int a = 0; a < 2; ++a)
#pragma unroll
            for (int b = 0; b < 2; ++b)
#pragma unroll
                for (int m = 0; m < 4; ++m)
#pragma unroll
                    for (int n = 0; n < 2; ++n) acc[a][b][m][n] = (f32x4){0.f, 0.f, 0.f, 0.f};
        }
        cur = nxt; cB = nB; ++ui;
#pragma unroll
        for (int h_ = 0; h_ < 2; ++h_) { vc[h_][0] = vn[h_][0]; vc[h_][1] = vn[h_][1]; }
        if constexpr (ALIGN_EPI) { if (wr == 1) PG8_BAR; }
    }
    PG8_WAIT_V(0);
    if constexpr (!ALIGN_EPI) { if (wr == 0) PG8_BAR; }
    PG8_BAR;
#undef PG8_ROWS
#undef PG8_SELV
#undef PG8_SA
#undef PG8_SB
#undef PG8_STAGE
#undef PG8_LDA
#undef PG8_LDB
#undef PG8_MMA
#undef PG8_WAIT_V
#undef PG8_WAIT_L
#undef PG8_BAR
#undef PG8_SCHED
}

struct GBParams { const bf16_t* XN; const bf16_t* PJ; int lda1; int col0, col1, col2, col3; const bf16_t* WG; const bf16_t* WB; };
struct GBUnit { int pm, pn, sub; };
template <class Epi>
__device__ __forceinline__ void gemm_gb_phase(PG8_LAS unsigned char* lds, const GBParams p, const StaticOrder& S, const Epi& E) {
    int tid_ = threadIdx.x; asm volatile("" : "+v"(tid_));
    const int tid = tid_, wid = __builtin_amdgcn_readfirstlane(tid >> 6), lane = tid & 63, wr = wid >> 2, wc = wid & 3, fr = lane & 15, fq = lane >> 4;
    constexpr int KP = 1024;
    unsigned voffA0[2], voffA1[2], voffB[2];
#pragma unroll
    for (int i = 0; i < 2; ++i) { int R, C; stage_rc(tid * 16 + i * 8192, R, C); const int Rb = (R & ~31) + perm32(R & 31);
        voffA0[i] = (unsigned)(R * KP + C) * 2u; voffA1[i] = (unsigned)(R * p.lda1 + C) * 2u; voffB[i] = (unsigned)(Rb * KP + C) * 2u; }
    const size_t kstep = (size_t)(BK * 2);
    const size_t hstepB = (size_t)HALF * KP * 2, tstepB = 2 * hstepB;
    const unsigned ldsw = (unsigned)wid * 1024u;
    const int aoff = lds_byte(wr * 64 + fr, fq * 8), boff = lds_byte(wc * 32 + fr, fq * 8);
#define PG8_SA(b, h) (((b) * 2 + (h)) * HTB)
#define PG8_SB(b, h) ((4 + (b) * 2 + (h)) * HTB)
#define PG8_STAGE(bufoff, gbase, voff) do { _Pragma("unroll") for (int _i = 0; _i < 2; ++_i) \
        __builtin_amdgcn_global_load_lds((const unsigned*)((const char*)(gbase) + (voff)[_i]), (PG8_LAS unsigned*)(lds + (bufoff) + ldsw + _i * 8192), 16, 0, 0); } while (0)
#define PG8_LDA(dst, b, h) do { _Pragma("unroll") for (int m = 0; m < 4; ++m) _Pragma("unroll") for (int k = 0; k < 2; ++k) dst[m][k] = *(const PG8_LAS bf16x8*)(lds + PG8_SA(b, h) + aoff + m * 2048 + k * 1024); } while (0)
#define PG8_LDB(dst, b, h) do { _Pragma("unroll") for (int n = 0; n < 2; ++n) _Pragma("unroll") for (int k = 0; k < 2; ++k) dst[n][k] = *(const PG8_LAS bf16x8*)(lds + PG8_SB(b, h) + boff + n * 2048 + k * 1024); } while (0)
#define PG8_MMA(ai, bj, At, Bt) do { __builtin_amdgcn_s_setprio(1); _Pragma("unroll") for (int m = 0; m < 4; ++m) _Pragma("unroll") for (int n = 0; n < 2; ++n) _Pragma("unroll") for (int k = 0; k < 2; ++k) \
        acc[ai][bj][m][n] = __builtin_amdgcn_mfma_f32_16x16x32_bf16(Bt[n][k], At[m][k], acc[ai][bj][m][n], 0, 0, 0); __builtin_amdgcn_s_setprio(0); } while (0)
#define PG8_WAIT_V(n) asm volatile("s_waitcnt vmcnt(" #n ")" ::: "memory")
#define PG8_WAIT_L(n) asm volatile("s_waitcnt lgkmcnt(" #n ")" ::: "memory")
#define PG8_BAR __builtin_amdgcn_s_barrier()
#define PG8_SCHED __builtin_amdgcn_sched_barrier(0)
#define GB_NEXT(idx, u, ok) do { Unit t_; ok = S.next((idx) >> 3, t_); u.pm = t_.pm; u.pn = t_.pn; u.sub = (idx) & 7; } while (0)
#define GB_OPS(u, Ap, Bp, hA, sel, ntv) do { const int br_ = (u).sub >> 1; sel = (u).sub & 1; ntv = sel ? 8 : 16; \
        const int col_ = (br_ == 0) ? p.col0 : (br_ == 1) ? p.col1 : (br_ == 2) ? p.col2 : p.col3; \
        hA = sel ? (size_t)HALF * p.lda1 * 2 : (size_t)HALF * KP * 2; \
        Ap = sel ? (const char*)(p.PJ + col_) + (size_t)(u).pm * 2 * hA : (const char*)p.XN + (size_t)(u).pm * 2 * hA; \
        Bp = (const char*)(sel ? p.WB : p.WG) + ((size_t)br_ * KP * KP + (size_t)(u).pn * BM * KP) * 2; } while (0)
#define GB_VA(sel, i) ((sel) ? voffA1[i] : voffA0[i])
#define GB_STAGE_A(bufoff, gbase, sel) do { _Pragma("unroll") for (int _i = 0; _i < 2; ++_i) \
        __builtin_amdgcn_global_load_lds((const unsigned*)((const char*)(gbase) + GB_VA(sel, _i)), (PG8_LAS unsigned*)(lds + (bufoff) + ldsw + _i * 8192), 16, 0, 0); } while (0)
    GBUnit cur, nxt; int ui = 0; bool ok0;
    GB_NEXT(0, cur, ok0);
    if (!ok0) return;
    f32x4 acc[2][2][4][2];
#pragma unroll
    for (int a = 0; a < 2; ++a)
#pragma unroll
        for (int b = 0; b < 2; ++b)
#pragma unroll
            for (int m = 0; m < 4; ++m)
#pragma unroll
                for (int n = 0; n < 2; ++n) acc[a][b][m][n] = (f32x4){0.f, 0.f, 0.f, 0.f};
    bf16x8 At[4][2], B0[2][2], B1[2][2];
    const char* cA; const char* cB; size_t chA; int csel, cnt;
    GB_OPS(cur, cA, cB, chA, csel, cnt);
    PG8_STAGE(PG8_SB(0, 0), cB, voffB); PG8_STAGE(PG8_SB(0, 1), cB + hstepB, voffB); GB_STAGE_A(PG8_SA(0, 0), cA, csel); GB_STAGE_A(PG8_SA(0, 1), cA + chA, csel);
    if (wr == 1) PG8_BAR;
    PG8_WAIT_V(2); PG8_BAR;
    PG8_STAGE(PG8_SB(1, 0), cB + kstep, voffB); GB_STAGE_A(PG8_SA(1, 0), cA + kstep, csel); PG8_STAGE(PG8_SB(1, 1), cB + hstepB + kstep, voffB);
    PG8_WAIT_V(6); PG8_BAR;
    for (;;) {
        bool has_next; GB_NEXT(ui + 1, nxt, has_next);
        const char* nA = cA; const char* nB = cB; size_t nhA = chA; int nsel = csel, nnt = cnt;
        if (has_next) GB_OPS(nxt, nA, nB, nhA, nsel, nnt);
        for (int t = 0; t < cnt; t += 2) {
            const bool last = (t == cnt - 2);
            const char* a1 = cA + (size_t)(t + 1) * kstep;
            const char* a2 = last ? nA : cA + (size_t)(t + 2) * kstep; const char* b2 = last ? nB : cB + (size_t)(t + 2) * kstep;
            const char* a3 = a2 + kstep; const char* b3 = b2 + kstep;
            const int xsel = last ? nsel : csel; const size_t xhA = last ? nhA : chA;
            PG8_LDB(B0, 0, 0); PG8_LDB(B1, 0, 1); PG8_SCHED; PG8_LDA(At, 0, 0); GB_STAGE_A(PG8_SA(1, 1), a1 + chA, csel);
            PG8_WAIT_V(8); PG8_WAIT_L(0); PG8_BAR; PG8_MMA(0, 0, At, B0); PG8_MMA(0, 1, At, B1); PG8_BAR; PG8_SCHED;
            PG8_LDA(At, 0, 1); PG8_STAGE(PG8_SB(0, 0), b2, voffB); PG8_STAGE(PG8_SB(0, 1), b2 + hstepB, voffB); GB_STAGE_A(PG8_SA(0, 0), a2, xsel);
            PG8_WAIT_V(8); PG8_WAIT_L(0); PG8_BAR; PG8_MMA(1, 0, At, B0); PG8_MMA(1, 1, At, B1); PG8_BAR; PG8_SCHED;
            PG8_LDB(B0, 1, 0); PG8_LDB(B1, 1, 1); PG8_SCHED; PG8_LDA(At, 1, 0); GB_STAGE_A(PG8_SA(0, 1), a2 + xhA, xsel);
            PG8_WAIT_V(8); PG8_WAIT_L(0); PG8_BAR; PG8_MMA(0, 0, At, B0); PG8_MMA(0, 1, At, B1); PG8_BAR; PG8_SCHED;
            PG8_LDA(At, 1, 1); PG8_STAGE(PG8_SB(1, 0), b3, voffB); PG8_STAGE(PG8_SB(1, 1), b3 + hstepB, voffB); GB_STAGE_A(PG8_SA(1, 0), a3, xsel);
            PG8_WAIT_V(8); PG8_WAIT_L(0); PG8_BAR; PG8_MMA(1, 0, At, B0); PG8_MMA(1, 1, At, B1); PG8_BAR; PG8_SCHED;
        }
        if (wr == 0) PG8_BAR;
        E(acc, cur, wr, wc, fr, fq);
        if (!has_next) break;
        if constexpr (!zeroes_of<Epi>::value) {
#pragma unroll
        for (int a = 0; a < 2; ++a)
#pragma unroll
            for (int b = 0; b < 2; ++b)
#pragma unroll
                for (int m = 0; m < 4; ++m)
#pragma unroll
                    for (int n = 0; n < 2; ++n) acc[a][b][m][n] = (f32x4){0.f, 0.f, 0.f, 0.f};
        }
        cur = nxt; cA = nA; cB = nB; chA = nhA; csel = nsel; cnt = nnt; ++ui;
        if (wr == 1) PG8_BAR;
    }
    PG8_WAIT_V(0);
    PG8_BAR;
#undef GB_NEXT
#undef GB_OPS
#undef GB_VA
#undef GB_STAGE_A
#undef PG8_SA
#undef PG8_SB
#undef PG8_STAGE
#undef PG8_LDA
#undef PG8_LDB
#undef PG8_MMA
#undef PG8_WAIT_V
#undef PG8_WAIT_L
#undef PG8_BAR
#undef PG8_SCHED
}
}
namespace pg8 {
#define EPI_LOOP_AM _Pragma("unroll") for (int ai = 0; ai < 2; ++ai) _Pragma("unroll") for (int m = 0; m < 4; ++m)
#define EPI_CLR(a0, a1) do { f32x4 z0_ = (f32x4){0.f, 0.f, 0.f, 0.f}, z1_ = (f32x4){0.f, 0.f, 0.f, 0.f}; asm volatile("" : "+v"(z0_), "+v"(z1_) :: "memory"); a0 = z0_; a1 = z1_; __builtin_amdgcn_sched_barrier(0); } while (0)

struct EpiProj {
    bf16_t* O; int ldc; float qs;
    static constexpr bool ZEROES = true;
    __device__ __forceinline__ void operator()(f32x4 (&acc)[2][2][4][2], const Unit& u, int wr, int wc, int fr, int fq) const {
        const int pn = u.pn; const bool act = (pn < 4) || (pn == 6) || (pn == 7); const float sc = (pn == 8 || pn == 9 || pn == 11 || pn == 12) ? qs : 1.f;
        const int row0 = u.pm * BM + wr * 64 + fr, col0 = pn * BM + wc * 32 + 8 * fq;
        EPI_LOOP_AM { bf16_t* rowp = O + (size_t)(row0 + ai * HALF + m * 16) * ldc + col0;
#pragma unroll
            for (int bj = 0; bj < 2; ++bj) { f32x4 v0 = acc[ai][bj][m][0], v1 = acc[ai][bj][m][1];
                if (act) {
#pragma unroll
                    for (int j = 0; j < 4; ++j) { v0[j] = gelu_tanh(v0[j]); v1[j] = gelu_tanh(v1[j]); } }
                v0 = v0 * sc; v1 = v1 * sc; *(u32x4*)(rowp + bj * HALF) = pack8(v0, v1); EPI_CLR(acc[ai][bj][m][0], acc[ai][bj][m][1]); } }
    }
};
__device__ __forceinline__ float rstd_from_ssq(const float* ssq, int row) { const f32x4* p = (const f32x4*)(ssq + (size_t)row * 16); const f32x4 a = p[0], b = p[1], c = p[2], d = p[3];
    const float s = ((a[0] + a[1]) + (a[2] + a[3])) + ((b[0] + b[1]) + (b[2] + b[3])) + ((c[0] + c[1]) + (c[2] + c[3])) + ((d[0] + d[1]) + (d[2] + d[3])); return 1.0f / sqrtf(s * (1.0f / 1024.0f) + 1e-6f); }
struct EpiBf16Rs {
    bf16_t* O; int ldc; const float* ssq;
    static constexpr bool ZEROES = true;
    __device__ __forceinline__ void operator()(f32x4 (&acc)[2][2][4][2], const Unit& u, int wr, int wc, int fr, int fq) const {
        const int row0 = u.pm * BM + wr * 64 + fr, col0 = u.pn * BM + wc * 32 + 8 * fq;
        EPI_LOOP_AM { const int row = row0 + ai * HALF + m * 16; bf16_t* rowp = O + (size_t)row * ldc + col0; const float r_ = rstd_from_ssq(ssq, row);
#pragma unroll
            for (int bj = 0; bj < 2; ++bj) { *(u32x4*)(rowp + bj * HALF) = pack8(acc[ai][bj][m][0] * r_, acc[ai][bj][m][1] * r_); EPI_CLR(acc[ai][bj][m][0], acc[ai][bj][m][1]); } }
    }
};
struct EpiBf16 {
    bf16_t* O; int ldc;
    static constexpr bool ZEROES = true;
    __device__ __forceinline__ void operator()(f32x4 (&acc)[2][2][4][2], const Unit& u, int wr, int wc, int fr, int fq) const {
        const int row0 = u.pm * BM + wr * 64 + fr, col0 = u.pn * BM + wc * 32 + 8 * fq;
        EPI_LOOP_AM { bf16_t* rowp = O + (size_t)(row0 + ai * HALF + m * 16) * ldc + col0;
#pragma unroll
            for (int bj = 0; bj < 2; ++bj) { *(u32x4*)(rowp + bj * HALF) = pack8(acc[ai][bj][m][0], acc[ai][bj][m][1]); EPI_CLR(acc[ai][bj][m][0], acc[ai][bj][m][1]); } }
    }
};
struct EpiGate {
    bf16_t* O; int ldc; const float* bias;
    __device__ __forceinline__ void operator()(const f32x4 (&acc)[2][2][4][2], const Unit& u, int wr, int wc, int fr, int fq) const {
        const int row0 = u.pm * BM + wr * 64 + fr, col0 = u.pn * BM + wc * 32 + 8 * fq;
        f32x4 bv[2][2];
#pragma unroll
        for (int bj = 0; bj < 2; ++bj)
#pragma unroll
            for (int n = 0; n < 2; ++n) bv[bj][n] = *(const f32x4*)(bias + col0 + bj * HALF + 4 * n);
        EPI_LOOP_AM { bf16_t* rowp = O + (size_t)(row0 + ai * HALF + m * 16) * ldc + col0;
#pragma unroll
            for (int bj = 0; bj < 2; ++bj) { f32x4 v0 = acc[ai][bj][m][0] + bv[bj][0], v1 = acc[ai][bj][m][1] + bv[bj][1];
#pragma unroll
                for (int j = 0; j < 4; ++j) { v0[j] = fast_sigmoid(v0[j]); v1[j] = fast_sigmoid(v1[j]); }
                *(u32x4*)(rowp + bj * HALF) = pack8(v0, v1); } }
    }
};
struct EpiBiasRaw {
    bf16_t* O; int ldc; const float* bias;
    __device__ __forceinline__ void operator()(const f32x4 (&acc)[2][2][4][2], const Unit& u, int wr, int wc, int fr, int fq) const {
        const int row0 = u.pm * BM + wr * 64 + fr, col0 = u.pn * BM + wc * 32 + 8 * fq;
        f32x4 bv[2][2];
#pragma unroll
        for (int bj = 0; bj < 2; ++bj)
#pragma unroll
            for (int n = 0; n < 2; ++n) bv[bj][n] = *(const f32x4*)(bias + col0 + bj * HALF + 4 * n);
        EPI_LOOP_AM { bf16_t* rowp = O + (size_t)(row0 + ai * HALF + m * 16) * ldc + col0;
#pragma unroll
            for (int bj = 0; bj < 2; ++bj) { f32x4 v0 = acc[ai][bj][m][0] + bv[bj][0], v1 = acc[ai][bj][m][1] + bv[bj][1];
                *(u32x4*)(rowp + bj * HALF) = pack8(v0, v1); } }
    }
};
struct EpiBranch {
    const bf16_t* G; bf16_t* Mg; int ldc; int first;
    __device__ __forceinline__ void operator()(const f32x4 (&acc)[2][2][4][2], const Unit& u, int wr, int wc, int fr, int fq) const {
        const int row0 = u.pm * BM + wr * 64 + fr, col0 = u.pn * BM + wc * 32 + 8 * fq;
        EPI_LOOP_AM { const size_t off = (size_t)(row0 + ai * HALF + m * 16) * ldc + col0;
#pragma unroll
            for (int bj = 0; bj < 2; ++bj) { const u32x4 g = *(const u32x4*)(G + off + bj * HALF); u32x4 mo = (u32x4){0u, 0u, 0u, 0u}; if (!first) mo = *(const u32x4*)(Mg + off + bj * HALF);
                const f32x4 a0 = acc[ai][bj][m][0], a1 = acc[ai][bj][m][1]; f32x4 v0, v1;
                v0[0] = bf_lo(mo.x) + bf_lo(g.x) * a0[0]; v0[1] = bf_hi(mo.x) + bf_hi(g.x) * a0[1]; v0[2] = bf_lo(mo.y) + bf_lo(g.y) * a0[2]; v0[3] = bf_hi(mo.y) + bf_hi(g.y) * a0[3];
                v1[0] = bf_lo(mo.z) + bf_lo(g.z) * a1[0]; v1[1] = bf_hi(mo.z) + bf_hi(g.z) * a1[1]; v1[2] = bf_lo(mo.w) + bf_lo(g.w) * a1[2]; v1[3] = bf_hi(mo.w) + bf_hi(g.w) * a1[3];
                *(u32x4*)(Mg + off + bj * HALF) = pack8(v0, v1); } }
    }
};
template <int VAR = 0> struct EpiGateBranch {
    bf16_t* G; bf16_t* Mg; int ldc; const float* bias;
    __device__ __forceinline__ void operator()(const f32x4 (&acc)[2][2][4][2], const GBUnit& u, int wr, int wc, int fr, int fq) const {
        const int row0 = u.pm * BM + wr * 64 + fr, col0 = u.pn * BM + wc * 32 + 8 * fq; const int br = u.sub >> 1;
        if ((u.sub & 1) == 0) {
            f32x4 bv[2][2];
#pragma unroll
            for (int bj = 0; bj < 2; ++bj)
#pragma unroll
                for (int n = 0; n < 2; ++n) bv[bj][n] = *(const f32x4*)(bias + br * 1024 + col0 + bj * HALF + 4 * n);
            EPI_LOOP_AM { bf16_t* rowp = G + (size_t)(row0 + ai * HALF + m * 16) * ldc + col0;
#pragma unroll
                for (int bj = 0; bj < 2; ++bj) { f32x4 v0 = acc[ai][bj][m][0] + bv[bj][0], v1 = acc[ai][bj][m][1] + bv[bj][1];
#pragma unroll
                    for (int j = 0; j < 4; ++j) { if (!(VAR & 1)) { v0[j] = fast_sigmoid(v0[j]); v1[j] = fast_sigmoid(v1[j]); } }
                    if (VAR < 4 || v0[0] == 12345.f) *(u32x4*)(rowp + bj * HALF) = pack8(v0, v1); } }
        } else {
            EPI_LOOP_AM { const size_t off = (size_t)(row0 + ai * HALF + m * 16) * ldc + col0;
#pragma unroll
                for (int bj = 0; bj < 2; ++bj) { u32x4 g = (u32x4){0x3f803f80u, 0x3f803f80u, 0x3f803f80u, 0x3f803f80u}; if (!(VAR & 2)) g = __builtin_nontemporal_load((const u32x4*)(G + off + bj * HALF)); u32x4 mo = (u32x4){0u, 0u, 0u, 0u}; if (br != 0 && !(VAR & 2)) mo = __builtin_nontemporal_load((const u32x4*)(Mg + off + bj * HALF));
                    const f32x4 a0 = acc[ai][bj][m][0], a1 = acc[ai][bj][m][1]; f32x4 v0, v1;
                    v0[0] = bf_lo(mo.x) + bf_lo(g.x) * a0[0]; v0[1] = bf_hi(mo.x) + bf_hi(g.x) * a0[1]; v0[2] = bf_lo(mo.y) + bf_lo(g.y) * a0[2]; v0[3] = bf_hi(mo.y) + bf_hi(g.y) * a0[3];
                    v1[0] = bf_lo(mo.z) + bf_lo(g.z) * a1[0]; v1[1] = bf_hi(mo.z) + bf_hi(g.z) * a1[1]; v1[2] = bf_lo(mo.w) + bf_lo(g.w) * a1[2]; v1[3] = bf_hi(mo.w) + bf_hi(g.w) * a1[3];
                    if (VAR < 4 || v0[0] == 12345.f) *(u32x4*)(Mg + off + bj * HALF) = pack8(v0, v1); } }
        }
    }
};
template <bool BASE_F32, bool SSQ_OUT = false> struct EpiResid {
    const float* X; bf16_t* H; int ldc; float* ssq;
    static constexpr bool ZEROES = true;
    __device__ __forceinline__ void operator()(f32x4 (&acc)[2][2][4][2], const Unit& u, int wr, int wc, int fr, int fq) const {
        const int row0 = u.pm * BM + wr * 64 + fr, col0 = u.pn * BM + wc * 32 + 8 * fq;
        EPI_LOOP_AM { const size_t off = (size_t)(row0 + ai * HALF + m * 16) * ldc + col0; float sq = 0.f;
#pragma unroll
            for (int bj = 0; bj < 2; ++bj) { f32x4 h0, h1;
                if (BASE_F32) { h0 = *(const f32x4*)(X + off + bj * HALF); h1 = *(const f32x4*)(X + off + bj * HALF + 4); }
                else { const u32x4 w = *(const u32x4*)(H + off + bj * HALF); h0 = (f32x4){bf_lo(w.x), bf_hi(w.x), bf_lo(w.y), bf_hi(w.y)}; h1 = (f32x4){bf_lo(w.z), bf_hi(w.z), bf_lo(w.w), bf_hi(w.w)}; }
                const u32x4 pk = pack8(h0 + acc[ai][bj][m][0], h1 + acc[ai][bj][m][1]); *(u32x4*)(H + off + bj * HALF) = pk; EPI_CLR(acc[ai][bj][m][0], acc[ai][bj][m][1]);
                if (SSQ_OUT) { const float e0 = bf_lo(pk.x), e1 = bf_hi(pk.x), e2 = bf_lo(pk.y), e3 = bf_hi(pk.y), e4 = bf_lo(pk.z), e5 = bf_hi(pk.z), e6 = bf_lo(pk.w), e7 = bf_hi(pk.w); sq += ((e0 * e0 + e1 * e1) + (e2 * e2 + e3 * e3)) + ((e4 * e4 + e5 * e5) + (e6 * e6 + e7 * e7)); } }
            if (SSQ_OUT) { sq += __shfl_xor(sq, 16); sq += __shfl_xor(sq, 32); if (fq == 0) ssq[(size_t)(row0 + ai * HALF + m * 16) * 16 + u.pn * 4 + wc] = sq; } }
    }
};
template <bool RS = false> struct EpiSwiglu {
    bf16_t* O; int ldc; const float* ssq;
    unsigned* waitc = nullptr; int nwait = 0; unsigned* tmo = nullptr;
    static constexpr bool ZEROES = true;
    __device__ __forceinline__ unsigned peek(const Unit& u) const { return (waitc != nullptr && u.pm < nwait) ? __hip_atomic_load(waitc + u.pm, __ATOMIC_RELAXED, __HIP_MEMORY_SCOPE_AGENT) : 4u; }
    __device__ __forceinline__ void operator()(f32x4 (&acc)[2][2][4][2], const Unit& u, int wr, int wc, int fr, int fq, unsigned seen = 0u) const {
        if (waitc != nullptr && u.pm < nwait && seen < 4u) {
            if (fr == 0 && fq == 0) { unsigned sp_ = 0u;
                while (__hip_atomic_load(waitc + u.pm, __ATOMIC_RELAXED, __HIP_MEMORY_SCOPE_AGENT) < 4u) { __builtin_amdgcn_s_sleep(2); if (++sp_ > (1u << 22)) { atomicAdd(tmo, 1u); break; } } }
            asm volatile("" ::: "memory"); }
        const int row0 = u.pm * BM + wr * 64 + fr, col0 = u.pn * HALF + wc * 32 + 8 * fq;
        EPI_LOOP_AM { const int row = row0 + ai * HALF + m * 16; bf16_t* rowp = O + (size_t)row * ldc + col0; f32x4 v0, v1; float r_ = 1.0f;
            if (RS) { const f32x4 q = *(const f32x4*)(ssq + (size_t)row * 16 + 4 * fq); float s = (q[0] + q[1]) + (q[2] + q[3]); s += __shfl_xor(s, 16); s += __shfl_xor(s, 32); r_ = 1.0f / sqrtf(s * (1.0f / 1024.0f) + 1e-6f); }
#pragma unroll
            for (int j = 0; j < 4; ++j) { const float g0 = acc[ai][0][m][0][j] * r_, g1 = acc[ai][0][m][1][j] * r_; v0[j] = g0 * fast_sigmoid(g0) * (acc[ai][1][m][0][j] * r_); v1[j] = g1 * fast_sigmoid(g1) * (acc[ai][1][m][1][j] * r_); }
            *(u32x4*)rowp = pack8(v0, v1); EPI_CLR(acc[ai][0][m][0], acc[ai][0][m][1]); EPI_CLR(acc[ai][1][m][0], acc[ai][1][m][1]); }
    }
};
struct EpiLru {
    const bf16_t* XC; bf16_t* OM; bf16_t* INP; int ldo; const float* ba; const float* bx; const float* lam;
    __device__ __forceinline__ void operator()(const f32x4 (&acc)[2][2][4][2], const Unit& u, int wr, int wc, int fr, int fq) const {
        const int row0 = u.pm * BM + wr * 64 + fr, ch0 = u.pn * HALF + wc * 32 + 8 * fq;
        float bav[8], bxv[8], sp[8];
#pragma unroll
        for (int j = 0; j < 8; ++j) { bav[j] = ba[ch0 + j]; bxv[j] = bx[ch0 + j]; sp[j] = -8.0f * 1.4426950408889634f * log1pf(__expf(-lam[ch0 + j])); }
        EPI_LOOP_AM { const int row = row0 + ai * HALF + m * 16; const u32x4 xw = *(const u32x4*)(XC + (size_t)row * 512 + ch0);
            const float xv[8] = {bf_lo(xw.x), bf_hi(xw.x), bf_lo(xw.y), bf_hi(xw.y), bf_lo(xw.z), bf_hi(xw.z), bf_lo(xw.w), bf_hi(xw.w)};
            f32x4 o0, o1, p0, p1;
#pragma unroll
            for (int j = 0; j < 8; ++j) { const float rp = (j < 4 ? acc[ai][0][m][0][j] : acc[ai][0][m][1][j - 4]) + bav[j], ip = (j < 4 ? acc[ai][1][m][0][j] : acc[ai][1][m][1][j - 4]) + bxv[j];
                const float r = fast_sigmoid(rp), ig = fast_sigmoid(ip); const float a = __builtin_amdgcn_exp2f(r * sp[j]); const float om = 1.0f - a; const float mult = __builtin_sqrtf(om * (1.0f + a));
                const float in = xv[j] * ig * mult; if (j < 4) { o0[j] = om; p0[j] = in; } else { o1[j - 4] = om; p1[j - 4] = in; } }
            *(u32x4*)(OM + (size_t)row * ldo + ch0) = pack8(o0, o1); *(u32x4*)(INP + (size_t)row * ldo + ch0) = pack8(p0, p1); }
    }
};
struct EpiMoeOut {
    bf16_t* H; const int* s2t; const float* sw; unsigned* done = nullptr;
    static constexpr bool ZEROES = true;
    __device__ __forceinline__ void operator()(f32x4 (&acc)[2][2][4][2], const Unit& u, int wr, int wc, int fr, int fq) const {
        const int row0 = u.pm * BM + wr * 64 + fr, col0 = u.pn * BM + wc * 32 + 8 * fq;
        EPI_LOOP_AM { const int slot = row0 + ai * HALF + m * 16; const int tok = s2t[slot]; const float w = sw[slot];
            if (tok >= 0) { bf16_t* rowp = H + (size_t)tok * 1024 + col0;
#pragma unroll
                for (int bj = 0; bj < 2; ++bj) { const u32x4 x = *(const u32x4*)(rowp + bj * HALF); const f32x4 h0 = (f32x4){bf_lo(x.x), bf_hi(x.x), bf_lo(x.y), bf_hi(x.y)}, h1 = (f32x4){bf_lo(x.z), bf_hi(x.z), bf_lo(x.w), bf_hi(x.w)};
                    *(u32x4*)(rowp + bj * HALF) = pack8(h0 + acc[ai][bj][m][0] * w, h1 + acc[ai][bj][m][1] * w); } }
            EPI_CLR(acc[ai][0][m][0], acc[ai][0][m][1]); EPI_CLR(acc[ai][1][m][0], acc[ai][1][m][1]); }
        if (done != nullptr && wr == 0 && wc == 0 && fr == 0 && fq == 0) (void)__hip_atomic_fetch_add(done + u.pm, 1u, __ATOMIC_RELAXED, __HIP_MEMORY_SCOPE_AGENT);
    }
};
struct EpiSoftmax {
    bf16_t* P; int ldc; PG8_LAS float* xch;
    __device__ __forceinline__ void operator()(f32x4 (&acc)[2][2][4][2], const Unit& u, int wr, int wc, int fr, int fq) const {
        const int row0 = u.pm * BM + wr * 64 + fr, col0 = u.pn * BM + wc * 32 + 8 * fq;
        EPI_LOOP_AM { float mx = -INFINITY;
#pragma unroll
            for (int bj = 0; bj < 2; ++bj)
#pragma unroll
                for (int n = 0; n < 2; ++n)
#pragma unroll
                    for (int j = 0; j < 4; ++j) mx = fmaxf(mx, acc[ai][bj][m][n][j]);
            mx = fmaxf(mx, __shfl_xor(mx, 16)); mx = fmaxf(mx, __shfl_xor(mx, 32));
            if (fq == 0) xch[(ai * HALF + wr * 64 + m * 16 + fr) * 4 + wc] = mx; }
        asm volatile("s_waitcnt lgkmcnt(0)" ::: "memory"); __builtin_amdgcn_s_barrier(); asm volatile("" ::: "memory");
        EPI_LOOP_AM { const int r = ai * HALF + wr * 64 + m * 16 + fr; const f32x4 q = *(const PG8_LAS f32x4*)(xch + r * 4); const float mx = fmaxf(fmaxf(q[0], q[1]), fmaxf(q[2], q[3])); float s = 0.f;
#pragma unroll
            for (int bj = 0; bj < 2; ++bj)
#pragma unroll
                for (int n = 0; n < 2; ++n)
#pragma unroll
                    for (int j = 0; j < 4; ++j) { const float p = __builtin_amdgcn_exp2f(acc[ai][bj][m][n][j] - mx); acc[ai][bj][m][n][j] = p; s += p; }
            s += __shfl_xor(s, 16); s += __shfl_xor(s, 32);
            if (fq == 0) xch[1024 + r * 4 + wc] = s; }
        asm volatile("s_waitcnt lgkmcnt(0)" ::: "memory"); __builtin_amdgcn_s_barrier(); asm volatile("" ::: "memory");
        EPI_LOOP_AM { const int r = ai * HALF + wr * 64 + m * 16 + fr; const f32x4 q = *(const PG8_LAS f32x4*)(xch + 1024 + r * 4); const float inv = __builtin_amdgcn_rcpf((q[0] + q[1]) + (q[2] + q[3]));
            bf16_t* rowp = P + (size_t)(row0 + ai * HALF + m * 16) * ldc + col0;
#pragma unroll
            for (int bj = 0; bj < 2; ++bj) *(u32x4*)(rowp + bj * HALF) = pack8(acc[ai][bj][m][0] * inv, acc[ai][bj][m][1] * inv); }
    }
};
#undef EPI_LOOP_AM
#undef EPI_CLR
}
#include <hip/hip_bf16.h>
#include <cmath>
namespace attn_body {
using bf16=__hip_bfloat16;
using bf16x8=__attribute__((ext_vector_type(8)))short;
using s16x4=__attribute__((ext_vector_type(4)))short;
using f32x16=__attribute__((ext_vector_type(16)))float;
using u32x4=__attribute__((ext_vector_type(4)))unsigned;
using f32x4=__attribute__((ext_vector_type(4)))float;
constexpr int SEQ=8192,D=64,DM=4352;
constexpr int NW=8,QBLK=32,QB=QBLK*NW,KVBLK=64,NQB=SEQ/QB;
__device__ __forceinline__ int crow(int r,int hi){return (r&3)+8*(r>>2)+4*hi;}
#define SBAR() __builtin_amdgcn_sched_barrier(0)
__device__ __forceinline__ void cmask(f32x16&p0,f32x16&p1,int jb,int qrel,int hi){
  const float NEG=-INFINITY; int kb=64*jb+4*hi;
  #pragma unroll
  for(int r=0;r<16;++r){int kv=kb+(r&3)+8*(r>>2); if(kv>qrel)p0[r]=NEG; if(kv+32>qrel)p1[r]=NEG;}
}

__device__ __forceinline__ void wmask(f32x16&p0,f32x16&p1,int v,int qrel,int hi){
  const float NEG=-INFINITY; int kb=64*v+4*hi;
  #pragma unroll
  for(int r=0;r<16;++r){int kv=kb+(r&3)+8*(r>>2); if(kv<=qrel)p0[r]=NEG; if(kv+32<=qrel)p1[r]=NEG;}
}
constexpr int NSLOT=3, SLOTB=8192;
constexpr int LDS_K=0, LDS_V=NSLOT*SLOTB, LDS_WS=2*NSLOT*SLOTB, LDS_OST=LDS_WS+NW*64*4, LDS_BYTES=LDS_OST+NW*4096;
constexpr float C2=0.125f*1.4426950408889634f;
__device__ __forceinline__ void glds16(const void*gsrc,unsigned lds_dst){unsigned keep;
  asm volatile("s_mov_b32 %0, m0\n\ts_mov_b32 m0, %2\n\ts_nop 0\n\tglobal_load_lds_dwordx4 %1, off\n\ts_mov_b32 m0, %0":"=&s"(keep):"v"(gsrc),"s"(lds_dst):"memory");}
__device__ __forceinline__ float max3f(float a,float b,float c){float r;asm("v_max3_f32 %0, %1, %2, %3":"=v"(r):"v"(a),"v"(b),"v"(c));return r;}
__device__ __forceinline__ float max2f(float a,float b){float r;asm("v_max_f32_e32 %0, %1, %2":"=v"(r):"v"(a),"v"(b));return r;}
__device__ __forceinline__ float fadd_s(float a,float b){float r;asm("v_add_f32_e32 %0, %1, %2":"=v"(r):"v"(a),"v"(b));return r;}
__device__ __forceinline__ float fsub_s(float a,float b){float r;asm("v_sub_f32_e32 %0, %1, %2":"=v"(r):"v"(a),"v"(b));return r;}
typedef float f32x2_t __attribute__((ext_vector_type(2))); typedef __bf16 bf16x2_t __attribute__((ext_vector_type(2)));
__device__ __forceinline__ unsigned cvtpk_s(float lo,float hi){f32x2_t v={lo,hi};bf16x2_t b=__builtin_convertvector(v,bf16x2_t);return __builtin_bit_cast(unsigned,b);}
#define WAIT_BAR(N) asm volatile("s_waitcnt vmcnt(" #N ") lgkmcnt(0)\n\ts_barrier":::"memory")

__device__ __forceinline__ void qkt(f32x16&p0,f32x16&p1,const char*Kslot,const bf16x8*qr,int r32,int hi){
  const char*kb=Kslot+hi*1024+r32*16;
  #pragma unroll
  for(int d0=0;d0<4;++d0){
    const bf16x8 b0=*reinterpret_cast<const bf16x8*>(kb+d0*2048);
    const bf16x8 b1=*reinterpret_cast<const bf16x8*>(kb+d0*2048+512);
    p0=__builtin_amdgcn_mfma_f32_32x32x16_bf16(b0,qr[d0],p0,0,0,0);p1=__builtin_amdgcn_mfma_f32_32x32x16_bf16(b1,qr[d0],p1,0,0,0);}
}
typedef __attribute__((address_space(3))) const char* lds_cptr;
typedef short v4i16_t __attribute__((ext_vector_type(4)));
__device__ __forceinline__ void kload8(bf16x8*kf,lds_cptr kp){
  kf[0]=*(const __attribute__((address_space(3))) bf16x8*)(kp);      kf[1]=*(const __attribute__((address_space(3))) bf16x8*)(kp+512);
  kf[2]=*(const __attribute__((address_space(3))) bf16x8*)(kp+2048); kf[3]=*(const __attribute__((address_space(3))) bf16x8*)(kp+2560);
  kf[4]=*(const __attribute__((address_space(3))) bf16x8*)(kp+4096); kf[5]=*(const __attribute__((address_space(3))) bf16x8*)(kp+4608);
  kf[6]=*(const __attribute__((address_space(3))) bf16x8*)(kp+6144); kf[7]=*(const __attribute__((address_space(3))) bf16x8*)(kp+6656);
}
__device__ __forceinline__ void kload2(bf16x8*kf,lds_cptr kp,int j){ kf[2*j]=*(const __attribute__((address_space(3))) bf16x8*)(kp+j*2048); kf[2*j+1]=*(const __attribute__((address_space(3))) bf16x8*)(kp+j*2048+512); }
__device__ __forceinline__ s16x4 vtr(lds_cptr p){ return __builtin_bit_cast(s16x4,__builtin_amdgcn_ds_read_tr16_b64_v4i16((__attribute__((address_space(3))) v4i16_t*)p)); }
__device__ __forceinline__ float rowmax(const f32x16&p0,const f32x16&p1){
  float a=max3f(p0[0],p0[1],p1[0]),b=max3f(p0[2],p0[3],p1[1]);a=max3f(a,p1[2],p1[3]);
  #pragma unroll
  for(int r=4;r<16;r+=4){a=max3f(a,p0[r],p0[r+1]);b=max3f(b,p0[r+2],p0[r+3]);a=max3f(a,p1[r],p1[r+1]);b=max3f(b,p1[r+2],p1[r+3]);}
  const float m=max2f(a,b);
  auto rr=__builtin_amdgcn_permlane32_swap(__float_as_uint(m),__float_as_uint(m),false,false);
  return max2f(__uint_as_float(rr[0]),__uint_as_float(rr[1]));
}
__device__ __forceinline__ void pv(f32x16*o,int vb,bf16x8 pa0,bf16x8 pa1,bf16x8 pa2,bf16x8 pa3){
  #pragma unroll
  for(int d0=0;d0<2;++d0){s16x4 lo[4],hi[4];
    #pragma unroll
    for(int ks=0;ks<4;++ks){
      asm volatile("ds_read_b64_tr_b16 %0,%1 offset:%c2":"=&v"(lo[ks]):"v"(vb),"i"(d0*4096+ks*1024):"memory");
      asm volatile("ds_read_b64_tr_b16 %0,%1 offset:%c2":"=&v"(hi[ks]):"v"(vb),"i"(d0*4096+ks*1024+512):"memory");}
    asm volatile("s_waitcnt lgkmcnt(0)":::"memory");SBAR();
    #define PK(k) (bf16x8){lo[k][0],lo[k][1],lo[k][2],lo[k][3],hi[k][0],hi[k][1],hi[k][2],hi[k][3]}
    o[d0]=__builtin_amdgcn_mfma_f32_32x32x16_bf16(pa0,PK(0),o[d0],0,0,0);
    o[d0]=__builtin_amdgcn_mfma_f32_32x32x16_bf16(pa1,PK(1),o[d0],0,0,0);
    o[d0]=__builtin_amdgcn_mfma_f32_32x32x16_bf16(pa2,PK(2),o[d0],0,0,0);
    o[d0]=__builtin_amdgcn_mfma_f32_32x32x16_bf16(pa3,PK(3),o[d0],0,0,0);
    #undef PK
  }
}

#ifndef ATTN_STORE16
#define ATTN_STORE16(p,v) (*(u32x4*)(p)=(v))
#endif
template<int THRL,int MODE> __device__ __forceinline__ void attn_unit(const bf16*Qw0,const bf16*__restrict__ Kh,const bf16*__restrict__ Vh,bf16*Ow0,const int NT,const int voff,const __attribute__((address_space(3))) float*ckrel,const int cqidx,const float sink2,const float slope2,char*shm){
  int tid_=threadIdx.x; asm volatile("":"+v"(tid_));
  const int tid=tid_,lane=tid&63,r32=lane&31,hi=lane>>5; const int wid=__builtin_amdgcn_readfirstlane(tid>>6);
  const bf16*Qw=Qw0+(long)(wid*QBLK)*DM;
  const unsigned lds0=(unsigned)(uintptr_t)shm;
  float*wsf=(float*)(shm+LDS_WS)+wid*64;
  const bf16*ksrc=Kh+(long)lane*DM+wid*8;
  const bf16*vsrc=Vh+(long)(16*(wid&3)+(lane>>2))*DM+(wid>>2)*32+(lane&3)*8;
  const unsigned kdst=lds0+LDS_K+wid*1024, vdst=lds0+LDS_V+wid*1024;
  #define DMA_K(t,slot) glds16(ksrc+(long)(t)*KVBLK*DM,(unsigned)__builtin_amdgcn_readfirstlane(kdst+(slot)))
  #define DMA_V(t,slot) glds16(vsrc+(long)(t)*KVBLK*DM,(unsigned)__builtin_amdgcn_readfirstlane(vdst+(slot)))
  const int vb0=(int)(lds0+LDS_V)+((lane>>4)&1)*32+(lane&3)*8+(4*hi+((lane&15)>>2))*64;
  const char*Kbase=shm+LDS_K; bf16x8 kf[8];
  const lds_cptr shm3=(lds_cptr)shm; const lds_cptr kp0=shm3+LDS_K+hi*1024+r32*16; const lds_cptr vp0=shm3+LDS_V+((lane>>4)&1)*32+(lane&3)*8+(4*hi+((lane&15)>>2))*64;
  DMA_K(0,0);DMA_V(0,0);DMA_K(1,SLOTB);
  bf16x8 qr[4];
  #pragma unroll
  for(int d0=0;d0<4;++d0)qr[d0]=*reinterpret_cast<const bf16x8*>(&Qw[(long)r32*DM+d0*16+hi*8]);
  const float cqv=(MODE==1)?(-slope2*(float)(128+wid*QBLK+r32)):ckrel[cqidx+wid*QBLK+r32];
  float mhat=-cqv,l_reg=0.f;     f32x16 o[2];o[0]=f32x16{};o[1]=f32x16{};
  const int qrel=wid*QBLK+r32;
  #define CMASK(P0,P1,t) do{int jb_=(t)-(NT-4); if(jb_>=0)cmask(P0,P1,jb_,qrel,hi); if(MODE==1){int v_=(t)+voff; if(v_<4)wmask(P0,P1,v_,qrel,hi);} }while(0)
  #define CINIT(P0,P1,t) do{ const __attribute__((address_space(3))) float*cp_=ckrel+(t)*64+4*hi; const float nm_=-mhat; \
    _Pragma("unroll") for(int rr_=0;rr_<4;++rr_){ const f32x4 a_=*(const __attribute__((address_space(3))) f32x4*)(cp_+8*rr_); const f32x4 b_=*(const __attribute__((address_space(3))) f32x4*)(cp_+32+8*rr_); \
      _Pragma("unroll") for(int j_=0;j_<4;++j_){P0[4*rr_+j_]=nm_-a_[j_];P1[4*rr_+j_]=nm_-b_[j_];} } }while(0)
  bool resc=false;
  #define START(P0,P1) do{ const float rm=rowmax(P0,P1); resc=false; \
    { const float dl=__builtin_fmaxf(rm,0.f);     mhat=fadd_s(mhat,dl); \
      _Pragma("unroll") for(int r=0;r<16;++r){P0[r]=fsub_s(P0[r],dl);P1[r]=fsub_s(P1[r],dl);} } \
    _Pragma("unroll") for(int r=0;r<16;++r)P0[r]=__builtin_amdgcn_exp2f(P0[r]); }while(0)
  #define RESC() do{ if(resc){ asm volatile("s_waitcnt lgkmcnt(0)":::"memory"); \
      _Pragma("unroll") for(int d_=0;d_<2;++d_) _Pragma("unroll") for(int r=0;r<16;++r)o[d_][r]*=wsf[crow(r,hi)]; } }while(0)
  f32x16 pA0,pA1,pB0,pB1;
  int sl_prev=0,sl_cur=0,sl_next=SLOTB;
  #define ROT() do{sl_prev=sl_cur;sl_cur=sl_next;sl_next=(sl_next==(NSLOT-1)*SLOTB)?0:sl_next+SLOTB;}while(0)
  DMA_K(2,2*SLOTB);
  WAIT_BAR(3);
  CINIT(pA0,pA1,0);qkt(pA0,pA1,Kbase,qr,r32,hi);asm volatile("s_nop 15\n\ts_nop 7":"+v"(pA0),"+v"(pA1));CMASK(pA0,pA1,0);
  START(pA0,pA1);
  _Pragma("unroll") for(int r=0;r<16;++r)pA1[r]=__builtin_amdgcn_exp2f(pA1[r]);
  WAIT_BAR(0);
  DMA_K(3,0);DMA_V(1,SLOTB);
  ROT();
  kload8(kf,kp0+sl_cur);
  WAIT_BAR(2);
  s16x4 vlo[8],vhi[8]; u32x4 pw0,pw1,pw2,pw3;
  #define PKW(P,B) cvtpk_s(P[B],P[B+1])
  #define PAF(k) __builtin_bit_cast(bf16x8,pw##k)
  #define VFR(i) (bf16x8){vlo[i][0],vlo[i][1],vlo[i][2],vlo[i][3],vhi[i][0],vhi[i][1],vhi[i][2],vhi[i][3]}
  #define PIN(x) asm volatile("":"+v"(x))
  #define MX3(a,b,c) __builtin_fmaxf(__builtin_fmaxf((a),(b)),(c))
  #define GAPA(MF,A0,A1,A2,A3,W0,W1,PW) do{ MF; sacc+=A0; sacc+=A1; sacc+=A2; sacc+=A3; PIN(sacc); W0; W1; PIN(PW); SBAR(); }while(0)
  #define EX(v) __builtin_amdgcn_exp2f(v)
  #define GAPB(MF,X,B) do{ MF; X[B]=EX(X[B]); X[B+1]=EX(X[B+1]); X[B+2]=EX(X[B+2]); X[B+3]=EX(X[B+3]); PIN(X); SBAR(); }while(0)
  #define VRD(i) do{ vlo[i]=vtr(vp_+(((i)>>2)*4096+((i)&3)*1024)); vhi[i]=vtr(vp_+(((i)>>2)*4096+((i)&3)*1024+512)); }while(0)
  #define KRD(G,j) do{ if(G){ kload2(kf,kp0+sl_next,j); SBAR(); } }while(0)
  #define STEP(C0,C1,P0,P1,t,GK,GV,GL) do{ SBAR(); CINIT(C0,C1,t); SBAR(); \
    const lds_cptr vp_=vp0+sl_prev; \
    VRD(0); SBAR(); float sacc=(P0[0]+P0[1]); \
    GAPA(C0=__builtin_amdgcn_mfma_f32_32x32x16_bf16(kf[0],qr[0],C0,0,0,0), P0[2],P0[3],P0[4],P0[5],     pw0[0]=PKW(P0,0), pw0[1]=PKW(P0,2), pw0); \
    VRD(4); SBAR(); GAPA(C1=__builtin_amdgcn_mfma_f32_32x32x16_bf16(kf[1],qr[0],C1,0,0,0), P0[6],P0[7],P0[8],P0[9],     pw0[2]=PKW(P0,4), pw0[3]=PKW(P0,6), pw0); \
    VRD(1); SBAR(); GAPA(C0=__builtin_amdgcn_mfma_f32_32x32x16_bf16(kf[2],qr[1],C0,0,0,0),   P0[10],P0[11],P0[12],P0[13], pw1[0]=PKW(P0,8), pw1[1]=PKW(P0,10), pw1); \
    VRD(5); SBAR(); GAPA(C1=__builtin_amdgcn_mfma_f32_32x32x16_bf16(kf[3],qr[1],C1,0,0,0),   P0[14],P0[15],P1[0],P1[1],   pw1[2]=PKW(P0,12),pw1[3]=PKW(P0,14), pw1); \
    VRD(2); SBAR(); GAPA(C0=__builtin_amdgcn_mfma_f32_32x32x16_bf16(kf[4],qr[2],C0,0,0,0),   P1[2],P1[3],P1[4],P1[5],     pw2[0]=PKW(P1,0), pw2[1]=PKW(P1,2), pw2); \
    VRD(6); SBAR(); GAPA(C1=__builtin_amdgcn_mfma_f32_32x32x16_bf16(kf[5],qr[2],C1,0,0,0),   P1[6],P1[7],P1[8],P1[9],     pw2[2]=PKW(P1,4), pw2[3]=PKW(P1,6), pw2); \
    VRD(3); SBAR(); GAPA(C0=__builtin_amdgcn_mfma_f32_32x32x16_bf16(kf[6],qr[3],C0,0,0,0),   P1[10],P1[11],P1[12],P1[13], pw3[0]=PKW(P1,8), pw3[1]=PKW(P1,10), pw3); \
    VRD(7); SBAR(); GAPA(C1=__builtin_amdgcn_mfma_f32_32x32x16_bf16(kf[7],qr[3],C1,0,0,0),   P1[14],P1[15],0.f,0.f,       pw3[2]=PKW(P1,12),pw3[3]=PKW(P1,14), pw3); \
    l_reg+=sacc; \
    if(GK){DMA_K((t)+3,sl_cur);} if(GV){DMA_V((t)+1,sl_next);} \
    CMASK(C0,C1,t); \
    { float a=MX3(C0[0],C0[1],C1[0]),b=MX3(C0[2],C0[3],C1[1]); a=MX3(a,C1[2],C1[3]); \
      _Pragma("unroll") for(int r=4;r<16;r+=4){a=MX3(a,C0[r],C0[r+1]);b=MX3(b,C0[r+2],C0[r+3]);a=MX3(a,C1[r],C1[r+1]);b=MX3(b,C1[r+2],C1[r+3]);} \
      float rm=__builtin_fmaxf(a,b); { auto rr=__builtin_amdgcn_permlane32_swap(__float_as_uint(rm),__float_as_uint(rm),false,false); rm=__builtin_fmaxf(__uint_as_float(rr[0]),__uint_as_float(rr[1])); } \
      resc=false; \
      if(__builtin_expect(__any(rm>(float)THRL),0)){ const float dl=__builtin_fmaxf(rm,0.f); mhat+=dl; \
        _Pragma("unroll") for(int r=0;r<16;++r){C0[r]-=dl;C1[r]-=dl;} \
        const float f=__builtin_amdgcn_exp2f(-dl); l_reg*=f; if(hi==0)wsf[r32]=f; resc=true; } } \
    SBAR(); \
    GAPB(o[0]=__builtin_amdgcn_mfma_f32_32x32x16_bf16(PAF(0),VFR(0),o[0],0,0,0), C0,0); \
    GAPB(o[1]=__builtin_amdgcn_mfma_f32_32x32x16_bf16(PAF(0),VFR(4),o[1],0,0,0), C0,4); \
    KRD(GL,0); GAPB(o[0]=__builtin_amdgcn_mfma_f32_32x32x16_bf16(PAF(1),VFR(1),o[0],0,0,0), C0,8); \
    KRD(GL,1); GAPB(o[1]=__builtin_amdgcn_mfma_f32_32x32x16_bf16(PAF(1),VFR(5),o[1],0,0,0), C0,12); \
    KRD(GL,2); GAPB(o[0]=__builtin_amdgcn_mfma_f32_32x32x16_bf16(PAF(2),VFR(2),o[0],0,0,0), C1,0); \
    KRD(GL,3); GAPB(o[1]=__builtin_amdgcn_mfma_f32_32x32x16_bf16(PAF(2),VFR(6),o[1],0,0,0), C1,4); \
    GAPB(o[0]=__builtin_amdgcn_mfma_f32_32x32x16_bf16(PAF(3),VFR(3),o[0],0,0,0), C1,8); \
    GAPB(o[1]=__builtin_amdgcn_mfma_f32_32x32x16_bf16(PAF(3),VFR(7),o[1],0,0,0), C1,12); \
    }while(0)
  int t=1;
  #undef CMASK
  #define CMASK(P0,P1,t) do{}while(0)
  for(;t+5<NT;t+=2){
    STEP(pB0,pB1,pA0,pA1,t,true,true,true);     WAIT_BAR(2); RESC(); ROT();
    STEP(pA0,pA1,pB0,pB1,t+1,true,true,true);   WAIT_BAR(2); RESC(); ROT();
  }
  #undef CMASK
  #define CMASK(P0,P1,t) do{int jb_=(t)-(NT-4); if(jb_>=0)cmask(P0,P1,jb_,qrel,hi); if(MODE==1){int v_=(t)+voff; if(v_<4)wmask(P0,P1,v_,qrel,hi);} }while(0)
  #define ENDW(tt) do{ if((tt)+3<NT){WAIT_BAR(2);} else if((tt)+2<NT){WAIT_BAR(1);} else {WAIT_BAR(0);} }while(0)
  for(;t+1<NT;t+=2){
    STEP(pB0,pB1,pA0,pA1,t,(t+3<NT),(t+1<NT),(t+1<NT));       ENDW(t);   RESC(); ROT();
    STEP(pA0,pA1,pB0,pB1,t+1,(t+4<NT),(t+2<NT),(t+2<NT));     ENDW(t+1); RESC(); ROT();
  }
  STEP(pB0,pB1,pA0,pA1,NT-1,false,false,false); RESC();
  { float sacc=pB0[0]+pB0[1]; _Pragma("unroll") for(int r=2;r<16;++r)sacc+=pB0[r]; _Pragma("unroll") for(int r=0;r<16;++r)sacc+=pB1[r]; l_reg+=sacc;
    pw0=(u32x4){PKW(pB0,0),PKW(pB0,2),PKW(pB0,4),PKW(pB0,6)};pw1=(u32x4){PKW(pB0,8),PKW(pB0,10),PKW(pB0,12),PKW(pB0,14)};pw2=(u32x4){PKW(pB1,0),PKW(pB1,2),PKW(pB1,4),PKW(pB1,6)};pw3=(u32x4){PKW(pB1,8),PKW(pB1,10),PKW(pB1,12),PKW(pB1,14)};
    SBAR(); pv(o,vb0+sl_cur,PAF(0),PAF(1),PAF(2),PAF(3)); }
  #undef PKW
  #undef PAF
  #undef VFR
  #undef PIN
  #undef MX3
  #undef GAPA
  #undef GAPB
  #undef EX
  #undef VRD
  #undef KRD
  #undef STEP
  #undef ENDW
  {auto rr=__builtin_amdgcn_permlane32_swap(__float_as_uint(l_reg),__float_as_uint(l_reg),false,false);l_reg=__uint_as_float(rr[0])+__uint_as_float(rr[1]);}
  if(MODE==1)l_reg+=__builtin_amdgcn_exp2f(sink2-mhat+slope2*(float)(128+qrel));
  if(hi==0)wsf[32+r32]=l_reg;asm volatile("s_waitcnt lgkmcnt(0)":::"memory");
  float rli[16];
  #pragma unroll
  for(int r=0;r<16;++r)rli[r]=__builtin_amdgcn_rcpf(wsf[32+crow(r,hi)]);
  bf16*Ow=Ow0+(long)(wid*QBLK)*DM;
  { bf16*stg=(bf16*)(shm+LDS_OST)+wid*2048;
    #pragma unroll
    for(int r=0;r<16;++r){const int orow=crow(r,hi);
      #pragma unroll
      for(int d0=0;d0<2;++d0)stg[orow*64+d0*32+r32]=__float2bfloat16(o[d0][r]*rli[r]);}
    asm volatile("s_waitcnt lgkmcnt(0)":::"memory");
    #pragma unroll
    for(int i=0;i<4;++i){const int row=i*8+(lane>>3),ch=lane&7; const u32x4 v=*(const u32x4*)(stg+row*64+ch*8); ATTN_STORE16(Ow+(long)row*DM+ch*8,v);} }
  asm volatile("s_waitcnt lgkmcnt(0)\n\ts_barrier":::"memory");
  #undef DMA_K
  #undef DMA_V
  #undef CMASK
  #undef CINIT
  #undef START
  #undef RESC
  #undef ROT
}
constexpr int ATTN_LDS_BYTES=LDS_BYTES;
#undef SBAR
#undef WAIT_BAR
}
constexpr int NWAVES = 8;
constexpr int BATCH = 8, SEQ = 8192, DM = 1024, M = BATCH * SEQ, DEPTH = 2, MEMLEN = 256;
constexpr int DIN = 4360, NPROJ = 4352, PP = NPROJ;
constexpr int DFF = 2816, NE = 8;
constexpr float EPS = 1e-6f, LOG2E = 1.4426950408889634f;
constexpr int C_AU = 0, C_AV = 512, C_BX = 1024, C_BY = 1536, C_CQ = 2048, C_CK = 2560, C_CV = 2688, C_DQ = 2816, C_DK = 3328, C_DV = 3840;
constexpr int C_INP = 512, C_OM = 1024;
constexpr int C_G = 512, C_MG = 3328;
constexpr int SLOTS = M + 2048;

constexpr size_t MiB = 1u << 20;
constexpr size_t WS_CTL = 0, CTL_ZERO_BYTES = 160 * 1024;
constexpr size_t WS_LC = 1 * MiB, WS_TOT = 3 * MiB, WS_LA = 4 * MiB, WS_LH = 4 * MiB + 512 * 1024, WS_ROUTE = 5 * MiB, WS_MOE = 6 * MiB;
constexpr size_t WS_MEMN = 8 * MiB, WS_KV = 16 * MiB, WS_WQK = 32 * MiB, WS_VWO = 48 * MiB;
constexpr size_t WS_WIN = 64 * MiB, WS_WG = 81 * MiB, WS_WB = 97 * MiB  , WS_WOUT = 113 * MiB, WS_WQ = 117 * MiB, WS_WKV = 119 * MiB, WS_WOC = 123 * MiB, WS_WLRU = 125 * MiB, WS_WSGU = 127 * MiB;
constexpr size_t WS_W13 = 128 * MiB, WS_W2 = 139 * MiB;
constexpr size_t WS_MW13 = 8 * MiB, WS_MW2 = 96 * MiB;
constexpr size_t WS_H = 145 * MiB;
constexpr size_t WS_XN = 273 * MiB, WS_XC = 401 * MiB, WS_PROJ = 465 * MiB, WS_END = 1009 * MiB;
static_assert(WS_MW2 + (size_t)8 * 1024 * 2816 * 2 <= WS_H && WS_MW13 + (size_t)8 * 5632 * 1024 * 2 <= WS_MW2, "moe weight overlay");
constexpr size_t WS_KN = WS_TOT + 768 * 1024, WS_QN = WS_KN + 64 * 128 * 4, WS_TLO = WS_QN + 64 * 32 * 4;
constexpr size_t WS_CUMT = WS_MOE;
constexpr size_t WS_SSQ = WS_MEMN;
constexpr size_t WS_LA8 = WS_WQK, WS_LH8 = WS_WQK + 4 * MiB;
constexpr size_t WS_XG = WS_PROJ, WS_ACT = WS_PROJ + 132 * MiB;
static_assert(WS_ACT + (size_t)SLOTS * DFF * 2 <= WS_END && (size_t)SLOTS * DM * 2 <= 132 * MiB && WS_PROJ + (size_t)M * PP * 2 <= WS_END, "ws map");
constexpr size_t MOE_S2T = 0, MOE_SW = 2 * (size_t)SLOTS * 4, MOE_TILE_E = 4 * (size_t)SLOTS * 4, MOE_NT = MOE_TILE_E + 2 * 512 * 4, MOE_WGCNT = MOE_NT + 64;
static_assert(MOE_WGCNT + 256 * 16 * 4 <= 2 * MiB, "moe tables");
constexpr int CW_BAR = 4096;
constexpr int CW_MOECNT = 16384;
constexpr int CW_G2DONE = 24576;
constexpr int CW_ATTQ = 20480;

constexpr int RING_OFF = 0, RING_BYTES = 131072;
constexpr int LDSCTL_OFF = 147456 - 1024, MISC_OFF = LDSCTL_OFF + 320;
constexpr int XCH_OFF = RING_BYTES + 4096;
constexpr int LDS_BYTES = 147456;
constexpr int CKL_OFF = 86016;

#define GAS __attribute__((address_space(1)))
#define LAS __attribute__((address_space(3)))
typedef unsigned short bf16;
typedef unsigned v4u __attribute__((ext_vector_type(4)));
typedef unsigned v2u __attribute__((ext_vector_type(2)));
typedef float f32x4 __attribute__((ext_vector_type(4)));
typedef short bf16x8 __attribute__((ext_vector_type(8)));
typedef float f32x16 __attribute__((ext_vector_type(16)));
typedef GAS unsigned gu32;
#define RLX_AGENT __ATOMIC_RELAXED, __HIP_MEMORY_SCOPE_AGENT
#define LDS_WAIT() asm volatile("s_waitcnt lgkmcnt(0)" ::: "memory")
#define VM_WAIT() asm volatile("s_waitcnt vmcnt(0)" ::: "memory")
__device__ __forceinline__ unsigned f2bf(float f) { unsigned u = __builtin_bit_cast(unsigned, f); return (u + 0x7fffu + ((u >> 16) & 1u)) >> 16; }
__device__ __forceinline__ unsigned pk2(float lo, float hi) { return f2bf(lo) | (f2bf(hi) << 16); }
__device__ __forceinline__ float bflo(unsigned w) { return __uint_as_float(w << 16); }
__device__ __forceinline__ float bfhi(unsigned w) { return __uint_as_float(w & 0xffff0000u); }
__device__ __forceinline__ float bf1(bf16 b) { return __uint_as_float(((unsigned)b) << 16); }

#define XB_TMO      128
#define XB_XCNT(j)  (256  + 64 * (j))
#define XB_XSUB(j)  (1280 + 64 * (j))
#define XB_XGEN(j)  (2304 + 64 * (j))
#define XB_TOP      3328
#define XB_TOPGEN   3392
#define XCD_BAR_WORDS 3456
#define XB_SPIN_CAP (1u << 18)
__device__ __forceinline__ unsigned xb_ld(unsigned* p)              { return __hip_atomic_load(p, __ATOMIC_RELAXED, __HIP_MEMORY_SCOPE_AGENT); }
__device__ __forceinline__ unsigned xb_add(unsigned* p, unsigned v) { return __hip_atomic_fetch_add(p, v, __ATOMIC_RELAXED, __HIP_MEMORY_SCOPE_AGENT); }
__device__ __forceinline__ unsigned xb_xcc_id() { return (unsigned)__builtin_amdgcn_s_getreg((3 << 11) | 20) & 0xFu; }
#define XB_SPIN(cond, bar) do { unsigned _sp = 0; while (cond) { __builtin_amdgcn_s_sleep(1); \
    if ((++_sp & 255u) == 0u) { if (xb_ld(&(bar)[XB_TMO])) break; if (_sp > XB_SPIN_CAP) { atomicAdd(&(bar)[XB_TMO], 1u); break; } } } } while (0)
struct XcdBarrier { unsigned* bar; unsigned x; volatile LAS unsigned* st; };
__device__ __forceinline__ XcdBarrier xcd_barrier_post(unsigned* bar, volatile LAS unsigned* st) {
    XcdBarrier b; b.bar = bar; b.x = xb_xcc_id(); b.st = st;
    if (threadIdx.x == 0) (void)xb_add(&bar[XB_XCNT(b.x)], 1u);
    return b;
}
__device__ __forceinline__ void xcd_barrier_complete(unsigned* bar, unsigned x, unsigned& nloc, unsigned& nx) {
    const unsigned G = gridDim.x * gridDim.y * gridDim.z;
    unsigned sum, cnt, mine, sp = 0u;
    for (;;) {
        sum = 0u; cnt = 0u; mine = 0u;
#pragma unroll
        for (unsigned j = 0; j < 16; ++j) { const unsigned c = xb_ld(&bar[XB_XCNT(j)]); sum += c; cnt += (c > 0u) ? 1u : 0u; mine = (j == x) ? c : mine; }
        if (sum == G) break;
        __builtin_amdgcn_s_sleep(1);
        if ((++sp & 255u) == 0u) { if (xb_ld(&bar[XB_TMO])) break; if (sp > XB_SPIN_CAP) { atomicAdd(&bar[XB_TMO], 1u); break; } }
    }
    nloc = mine > 0u ? mine : 1u; nx = cnt > 0u ? cnt : 1u;
}
__device__ __forceinline__ void xcd_barrier(const XcdBarrier& b) {
    asm volatile("s_waitcnt vmcnt(0)" ::: "memory");
    __syncthreads();
    if (threadIdx.x == 0) {
        unsigned* bar = b.bar;
        __builtin_amdgcn_s_waitcnt(0);
        unsigned nloc = b.st[0], nx = b.st[1];
        if (nloc == 0u) { xcd_barrier_complete(bar, b.x, nloc, nx); b.st[0] = nloc; b.st[1] = nx; }
        const unsigned old = xb_add(&bar[XB_XSUB(b.x)], 1u);
        const unsigned gen = old / nloc;
        if (old + 1u == (gen + 1u) * nloc) {
            __builtin_amdgcn_fence(__ATOMIC_RELEASE, "agent");
            asm volatile("s_waitcnt vmcnt(0)" ::: "memory");
            const unsigned og = xb_add(&bar[XB_TOP], 1u);
            const unsigned tg = og / nx;
            if (og + 1u == (tg + 1u) * nx) xb_add(&bar[XB_TOPGEN], 1u);
            else XB_SPIN(xb_ld(&bar[XB_TOPGEN]) == tg, bar);
            __builtin_amdgcn_fence(__ATOMIC_ACQUIRE, "agent");
            xb_add(&bar[XB_XGEN(b.x)], 1u);
            asm volatile("s_waitcnt vmcnt(0)" ::: "memory");
        } else {
            XB_SPIN(xb_ld(&bar[XB_XGEN(b.x)]) == gen, bar);
            __builtin_amdgcn_fence(__ATOMIC_ACQUIRE, "agent");
            asm volatile("s_waitcnt vmcnt(0)" ::: "memory");
        }
    }
    __syncthreads();
}

struct Frame {
    LAS unsigned char* lds;
    int tid, lane, wave;
    int vcu, G;
};
__device__ __forceinline__ float wave_sum(float v) {
#pragma unroll
    for (int o = 1; o < 64; o <<= 1) v += __shfl_xor(v, o);
    return v;
}

template <int MAP> __device__ __forceinline__ int tr_drow(int n, int p0) {
    if (MAP == 0) return p0 + n;
    const int j = n < DFF ? n : n - DFF; return p0 + (j >> 7) * 256 + (n < DFF ? 0 : 128) + (j & 127);
}
template <int MAP> __device__ __forceinline__ void tr_item(const float* W, int ld_src, int N, bf16* WT, int ld_dst, int p0, int coff, LAS float* scr, int item, int lane, float sc = 1.0f, const float* gk = nullptr) {
    const int nblk = N / 32, kb = item / nblk, nb = item % nblk, k0 = 64 * kb, n0 = 32 * nb;
#pragma unroll
    for (int i = 0; i < 8; ++i) { const int kk = 8 * i + (lane >> 3), n4 = (lane & 7) * 4;
        const f32x4 v = *(const GAS f32x4*)(W + (size_t)(k0 + kk) * ld_src + n0 + n4); const float s_ = gk ? sc * gk[k0 + kk] : sc;
        scr[kk * 33 + n4] = v.x * s_; scr[kk * 33 + n4 + 1] = v.y * s_; scr[kk * 33 + n4 + 2] = v.z * s_; scr[kk * 33 + n4 + 3] = v.w * s_; }
    LDS_WAIT(); asm volatile("" ::: "memory");
    const int c = lane & 7;
#pragma unroll
    for (int j = 0; j < 4; ++j) { const int n = (lane >> 3) + 8 * j; const LAS float* s = scr + (8 * c) * 33 + n;
        v4u o; o.x = pk2(s[0 * 33], s[1 * 33]); o.y = pk2(s[2 * 33], s[3 * 33]); o.z = pk2(s[4 * 33], s[5 * 33]); o.w = pk2(s[6 * 33], s[7 * 33]);
        *(GAS v4u*)(WT + (size_t)tr_drow<MAP>(n0 + n, p0) * ld_dst + coff + k0 + 8 * c) = o; }
    LDS_WAIT(); asm volatile("" ::: "memory");
}
struct Args { const float* in[33]; float* out; unsigned char* ws; int ph_lo, ph_hi; };
enum { I_X = 0, I_MEM, I_NORM_MIX, I_W_IN, I_SGU_G, I_SGU_W, I_SGU_B, I_CONV_W, I_CONV_B, I_RG_WA, I_RG_BA, I_RG_WX, I_RG_BX, I_RG_LAMBDA, I_SWA_SINKS, I_FOX_BF, I_W_BRANCH, I_W_GATE, I_B_GATE, I_W_OUT,
       I_NORM_CROSS, I_NORM_MEM, I_WQ_C, I_WKV_C, I_WO_C, I_NORM_FFN, I_DENSE_W13, I_DENSE_W2, I_ROUTER_W, I_ROUTER_B, I_MOE_W13, I_MOE_W2, I_NORM_FINAL };

__device__ __forceinline__ void p0_prologue(const Frame& F, const __attribute__((address_space(4))) Args* ap) {
    const __attribute__((address_space(4))) Args& a = *ap;
    LAS float* scr = (LAS float*)(F.lds + RING_OFF + F.wave * 16384);
    const int gw = F.vcu * NWAVES + F.wave, NGW = F.G * NWAVES;
    unsigned char* ws = a.ws;
    int it = gw;
#define TR_JOB(MAP, src, ldsrc, K, N, dst, lddst, p0, coff) { const int ni_ = ((K) / 64) * ((N) / 32); for (; it < ni_; it += NGW) tr_item<MAP>((src), (ldsrc), (N), (dst), (lddst), (p0), (coff), scr, it, F.lane); it -= ni_; }
    for (int l = 0; l < DEPTH; ++l) {
        TR_JOB(0, a.in[I_W_IN] + (size_t)l * DM * DIN, DIN, DM, NPROJ, (bf16*)(ws + WS_WIN) + (size_t)l * NPROJ * DM, DM, 0, 0)
        for (int br = 0; br < 4; ++br) {
            TR_JOB(0, a.in[I_W_GATE] + (size_t)(l * 4 + br) * DM * DM, DM, DM, DM, (bf16*)(ws + WS_WG) + (size_t)(l * 4 + br) * DM * DM, DM, 0, 0)
            TR_JOB(0, a.in[I_W_BRANCH] + (size_t)(l * 4 + br) * 512 * DM, DM, 512, DM, (bf16*)(ws + WS_WB) + (size_t)(l * 4 + br) * DM * DM, DM, 0, 0)
        }
        TR_JOB(0, a.in[I_W_OUT] + (size_t)l * DM * DM, DM, DM, DM, (bf16*)(ws + WS_WOUT) + (size_t)l * DM * DM, DM, 0, 0)
        TR_JOB(0, a.in[I_WKV_C] + (size_t)l * DM * 1024, 1024, DM, 1024, (bf16*)(ws + WS_WKV) + (size_t)l * 1024 * DM, DM, 0, 0)
        TR_JOB(0, a.in[I_WO_C] + (size_t)l * 512 * DM, DM, 512, DM, (bf16*)(ws + WS_WOC) + (size_t)l * DM * 512, 512, 0, 0)
        { const int ni_ = (DM / 64) * (512 / 32); for (; it < ni_; it += NGW) tr_item<0>(a.in[I_WQ_C] + (size_t)l * DM * 512, 512, 512, (bf16*)(ws + WS_WQ) + (size_t)l * 512 * DM, DM, 0, 0, scr, it, F.lane, 0.08838834764831845f * LOG2E, a.in[I_NORM_CROSS] + (size_t)l * DM); it -= ni_; }
        for (int h = 0; h < 4; ++h) {
            TR_JOB(0, a.in[I_RG_WA] + (size_t)(l * 4 + h) * 128 * 128, 128, 128, 128, (bf16*)(ws + WS_WLRU) + (size_t)l * 1024 * 128, 128, h * 256, 0)
            TR_JOB(0, a.in[I_RG_WX] + (size_t)(l * 4 + h) * 128 * 128, 128, 128, 128, (bf16*)(ws + WS_WLRU) + (size_t)l * 1024 * 128, 128, h * 256 + 128, 0)
        }
    }
    { const int ni_ = (DM / 64) * (2 * DFF / 32); for (; it < ni_; it += NGW) tr_item<1>(a.in[I_DENSE_W13], 2 * DFF, 2 * DFF, (bf16*)(ws + WS_W13), DM, 0, 0, scr, it, F.lane, 1.0f, a.in[I_NORM_FFN]); it -= ni_; }
    TR_JOB(0, a.in[I_DENSE_W2], DM, DFF, DM, (bf16*)(ws + WS_W2), DFF, 0, 0)
#undef TR_JOB
    const size_t gt = (size_t)F.vcu * (NWAVES * 64) + F.tid, NGT = (size_t)F.G * NWAVES * 64;
    for (size_t i = gt; i < (size_t)DEPTH * 4 * 128 * 128 / 4; i += NGT) { const f32x4 v = ((const GAS f32x4*)a.in[I_SGU_W])[i]; const int t = (int)((i >> 5) & 127), s0 = (int)(i & 31) * 4;
        v2u o; o.x = pk2(s0 <= t ? v.x : 0.f, s0 + 1 <= t ? v.y : 0.f); o.y = pk2(s0 + 2 <= t ? v.z : 0.f, s0 + 3 <= t ? v.w : 0.f); ((GAS v2u*)(ws + WS_WSGU))[i] = o; }
    for (int r = gw; r < DEPTH * BATCH * MEMLEN; r += NGW) { const int l = r / (BATCH * MEMLEN), row = r % (BATCH * MEMLEN);
        const GAS f32x4* xr = (const GAS f32x4*)(a.in[I_MEM] + (size_t)row * DM) + F.lane; const GAS f32x4* gr = (const GAS f32x4*)(a.in[I_NORM_MEM] + (size_t)l * DM) + F.lane;
        f32x4 v[4]; float s = 0.f;
#pragma unroll
        for (int j = 0; j < 4; ++j) { v[j] = xr[64 * j]; s += (v[j].x * v[j].x + v[j].y * v[j].y) + (v[j].z * v[j].z + v[j].w * v[j].w); }
        const float rstd = 1.f / sqrtf(wave_sum(s) * (1.f / DM) + EPS);
        GAS v2u* o8 = (GAS v2u*)(ws + WS_MEMN + (size_t)r * DM * 2) + F.lane;
#pragma unroll
        for (int j = 0; j < 4; ++j) { const f32x4 g = gr[64 * j]; v2u o; o.x = pk2(v[j].x * rstd * g.x, v[j].y * rstd * g.y); o.y = pk2(v[j].z * rstd * g.z, v[j].w * rstd * g.w); o8[64 * j] = o; } }
}

__device__ __forceinline__ void moe_convert_phase(const Frame& F, const __attribute__((address_space(4))) Args* ap) {
    const __attribute__((address_space(4))) Args& a = *ap;
    LAS float* scr = (LAS float*)(F.lds + RING_OFF + F.wave * 16384);
    const int gw = F.vcu * NWAVES + F.wave, NGW = F.G * NWAVES;
    unsigned char* ws = a.ws;
    int it = gw;
#define TR_JOB(MAP, src, ldsrc, K, N, dst, lddst, p0, coff) { const int ni_ = ((K) / 64) * ((N) / 32); for (; it < ni_; it += NGW) tr_item<MAP>((src), (ldsrc), (N), (dst), (lddst), (p0), (coff), scr, it, F.lane); it -= ni_; }
    for (int e = 0; e < NE; ++e) {
        TR_JOB(1, a.in[I_MOE_W13] + (size_t)e * DM * 2 * DFF, 2 * DFF, DM, 2 * DFF, (bf16*)(ws + WS_MW13), DM, e * 2 * DFF, 0)
        TR_JOB(0, a.in[I_MOE_W2] + (size_t)e * DFF * DM, DM, DFF, DM, (bf16*)(ws + WS_MW2) + (size_t)e * DM * DFF, DFF, 0, 0)
    }
#undef TR_JOB
}

template <int MODE, bool IN_F32> __device__ __forceinline__ void norm_phase(const Frame& F, const void* hin, const float* gain, bf16* XN, const float* W8, int w8_ld, const float* b8, unsigned char* ws) {
    LAS float* rowv = (LAS float*)(F.lds + RING_OFF);
    LAS float* segt = rowv + 256 * 8;
    LAS int* lcnt = (LAS int*)(segt + 64);
    f32x4 g4[4];
#pragma unroll
    for (int j = 0; j < 4; ++j) g4[j] = ((const GAS f32x4*)gain)[F.lane + 64 * j];
    float w8[8][16];
    if (MODE != 0) {
        LAS float* wl = (LAS float*)(F.lds + RING_OFF + 16384);
        for (int q = F.tid; q < 2048; q += NWAVES * 64) { const int k = q >> 1, hf = (q & 1) * 4; *(LAS f32x4*)(wl + k * 8 + hf) = *(const GAS f32x4*)(W8 + (size_t)k * w8_ld + hf); }
        LDS_WAIT(); __syncthreads();
#pragma unroll
        for (int j = 0; j < 4; ++j)
#pragma unroll
            for (int i = 0; i < 4; ++i) { const f32x4 a = *(const LAS f32x4*)(wl + (4 * F.lane + 256 * j + i) * 8), b = *(const LAS f32x4*)(wl + (4 * F.lane + 256 * j + i) * 8 + 4);
                w8[0][j * 4 + i] = a[0]; w8[1][j * 4 + i] = a[1]; w8[2][j * 4 + i] = a[2]; w8[3][j * 4 + i] = a[3]; w8[4][j * 4 + i] = b[0]; w8[5][j * 4 + i] = b[1]; w8[6][j * 4 + i] = b[2]; w8[7][j * 4 + i] = b[3]; }
        LDS_WAIT(); __syncthreads();
    }
    for (int c = blockIdx.x; c < M / 256; c += F.G) {
        if (MODE == 2) { if (F.tid < 16) lcnt[F.tid] = 0; }
        constexpr int RB = (MODE == 0) ? 4 : 2;
        for (int rr = 0; rr < 32; rr += RB) {
            f32x4 v[RB][4];
#pragma unroll
            for (int q = 0; q < RB; ++q) { const size_t row = (size_t)c * 256 + F.wave * 32 + rr + q;
                if (IN_F32) { const GAS f32x4* xr = (const GAS f32x4*)((const float*)hin + row * DM) + F.lane;
#pragma unroll
                    for (int j = 0; j < 4; ++j) v[q][j] = xr[64 * j];
                } else { const GAS v2u* xr = (const GAS v2u*)((const bf16*)hin + row * DM) + F.lane;
#pragma unroll
                    for (int j = 0; j < 4; ++j) { const v2u w = xr[64 * j]; v[q][j] = (f32x4){bflo(w.x), bfhi(w.x), bflo(w.y), bfhi(w.y)}; } } }
#pragma unroll
            for (int q = 0; q < RB; ++q) { const int rl = F.wave * 32 + rr + q; const size_t row = (size_t)c * 256 + rl; float s = 0.f;
#pragma unroll
                for (int j = 0; j < 4; ++j) s += (v[q][j].x * v[q][j].x + v[q][j].y * v[q][j].y) + (v[q][j].z * v[q][j].z + v[q][j].w * v[q][j].w);
                const float rstd = 1.f / sqrtf(wave_sum(s) * (1.f / DM) + EPS);
                GAS v2u* o8 = (GAS v2u*)(XN + row * DM) + F.lane;
#pragma unroll
                for (int j = 0; j < 4; ++j) { v[q][j] = v[q][j] * rstd * g4[j]; v2u o; o.x = pk2(v[q][j].x, v[q][j].y); o.y = pk2(v[q][j].z, v[q][j].w); o8[64 * j] = o; }
                if (MODE != 0) {
                    float d[8];
#pragma unroll
                    for (int e = 0; e < 8; ++e) { float qq = 0.f;
#pragma unroll
                        for (int j = 0; j < 4; ++j) qq += (v[q][j].x * w8[e][j * 4] + v[q][j].y * w8[e][j * 4 + 1]) + (v[q][j].z * w8[e][j * 4 + 2] + v[q][j].w * w8[e][j * 4 + 3]);
                        d[e] = wave_sum(qq); }
                    if (F.lane == 0) {
#pragma unroll
                        for (int e = 0; e < 8; ++e) rowv[rl * 8 + e] = d[e] + b8[e]; }
                } }
        }
        if (MODE == 1) {
            LDS_WAIT(); __syncthreads();
            if (F.tid < 64) { const int hd = F.tid & 7, sg = F.tid >> 3; float run = 0.f;
                for (int t = 0; t < 32; ++t) { const int idx = (sg * 32 + t) * 8 + hd; const float z = rowv[idx]; const float ls = (fminf(z, 0.f) - log1pf(__expf(-fabsf(z)))) * LOG2E; run += ls; rowv[idx] = run; }
                segt[sg * 8 + hd] = run; }
            LDS_WAIT(); __syncthreads();
            { const int rl = F.tid >> 1, h0 = (F.tid & 1) * 4; f32x4 o;
#pragma unroll
                for (int i = 0; i < 4; ++i) { float p = 0.f; for (int sg = 0; sg < (rl >> 5); ++sg) p += segt[sg * 8 + h0 + i]; o[i] = rowv[rl * 8 + h0 + i] + p; }
                *(GAS f32x4*)((float*)(ws + WS_LC) + ((size_t)c * 256 + rl) * 8 + h0) = o;
                if (rl == 255) *(GAS f32x4*)((float*)(ws + WS_TOT) + (size_t)c * 8 + h0) = o; }
            LDS_WAIT(); __syncthreads();
        }
        if (MODE == 2) {
            LDS_WAIT(); __syncthreads();
            if (F.tid < 256) { float lg[8];
#pragma unroll
                for (int e = 0; e < 8; ++e) lg[e] = rowv[F.tid * 8 + e];
                int e0 = 0; float v0 = lg[0];
#pragma unroll
                for (int e = 1; e < 8; ++e) if (lg[e] > v0) { v0 = lg[e]; e0 = e; }
                int e1 = -1; float v1 = -INFINITY;
#pragma unroll
                for (int e = 0; e < 8; ++e) if (e != e0 && lg[e] > v1) { v1 = lg[e]; e1 = e; }
                const float w0 = 1.0f / (1.0f + __expf(v1 - v0)), w1 = 1.0f - w0;
                v4u o; o.x = (unsigned)e0; o.y = (unsigned)e1; o.z = __float_as_uint(w0); o.w = __float_as_uint(w1);
                *(GAS v4u*)(ws + WS_ROUTE + ((size_t)c * 256 + F.tid) * 16) = o;
                atomicAdd((int*)lcnt + e0, 1); atomicAdd((int*)lcnt + 8 + e1, 1); }
            LDS_WAIT(); __syncthreads();
            if (F.tid < 16) { const int n = lcnt[F.tid]; ((int*)(ws + WS_MOE + MOE_WGCNT))[c * 16 + F.tid] = n; __hip_atomic_fetch_add((int*)(ws + WS_CTL) + CW_MOECNT + F.tid, n, RLX_AGENT); }
            LDS_WAIT(); __syncthreads();
        }
    }
}

__device__ __forceinline__ void conv_phase(const Frame& F, const bf16* PROJ, const float* cw, const float* cb, bf16* XC) {
    const int gw = F.vcu * NWAVES + F.wave, NGW = F.G * NWAVES, c = F.lane * 8;
    float w[4][8], b[8];
#pragma unroll
    for (int k = 0; k < 4; ++k) { const f32x4 w0 = *(const GAS f32x4*)(cw + k * 512 + c), w1 = *(const GAS f32x4*)(cw + k * 512 + c + 4);
#pragma unroll
        for (int j = 0; j < 4; ++j) { w[k][j] = w0[j]; w[k][4 + j] = w1[j]; } }
    { const f32x4 b0 = *(const GAS f32x4*)(cb + c), b1 = *(const GAS f32x4*)(cb + c + 4);
#pragma unroll
        for (int j = 0; j < 4; ++j) { b[j] = b0[j]; b[4 + j] = b1[j]; } }
#pragma unroll 1
    for (int run = gw; run < M / 16; run += NGW) { const int t0 = run * 16; const bool head = (t0 & (SEQ - 1)) == 0;
        const bf16* src = PROJ + (size_t)t0 * PP + C_BX + c;
        v4u x0 = (v4u){0u, 0u, 0u, 0u}, x1 = x0, x2 = x0;
        if (!head) { x0 = *(const GAS v4u*)(src - 3 * (size_t)PP); x1 = *(const GAS v4u*)(src - 2 * (size_t)PP); x2 = *(const GAS v4u*)(src - (size_t)PP); }
#pragma unroll 4
        for (int r = 0; r < 16; ++r) { const v4u x3 = *(const GAS v4u*)(src + (size_t)r * PP);
            float acc[8];
#pragma unroll
            for (int j = 0; j < 8; ++j) acc[j] = b[j];
#define CONV_TAP(k, V_) acc[0] += w[k][0] * bflo(V_.x); acc[1] += w[k][1] * bfhi(V_.x); acc[2] += w[k][2] * bflo(V_.y); acc[3] += w[k][3] * bfhi(V_.y); acc[4] += w[k][4] * bflo(V_.z); acc[5] += w[k][5] * bfhi(V_.z); acc[6] += w[k][6] * bflo(V_.w); acc[7] += w[k][7] * bfhi(V_.w);
            CONV_TAP(0, x0) CONV_TAP(1, x1) CONV_TAP(2, x2) CONV_TAP(3, x3)
#undef CONV_TAP
            v4u o; o.x = pk2(acc[0], acc[1]); o.y = pk2(acc[2], acc[3]); o.z = pk2(acc[4], acc[5]); o.w = pk2(acc[6], acc[7]);
            *(GAS v4u*)(XC + (size_t)(t0 + r) * 512 + c) = o;
            x0 = x1; x1 = x2; x2 = x3; }
    }
}

__device__ __forceinline__ void small_tile(const bf16* A, int lda, const bf16* Bt, int ldb, float scale, bf16* C, int ldc, int lane) {
    const int r31 = lane & 31, hi = lane >> 5; f32x16 acc = {};
#pragma unroll
    for (int ks = 0; ks < 8; ++ks) { const bf16x8 av = *(const GAS bf16x8*)(A + (size_t)r31 * lda + ks * 16 + 8 * hi); const bf16x8 bv = *(const GAS bf16x8*)(Bt + (size_t)r31 * ldb + ks * 16 + 8 * hi);
        acc = __builtin_amdgcn_mfma_f32_32x32x16_bf16(av, bv, acc, 0, 0, 0); }
#pragma unroll
    for (int r = 0; r < 16; ++r) { const int row = (r & 3) + 8 * (r >> 2) + 4 * hi; C[(size_t)row * ldc + r31] = (bf16)f2bf(acc[r] * scale); }
}
__device__ __forceinline__ void crossprep_phase(const Frame& F, const bf16* KV  , const bf16* WQ  , const bf16* WOC  , bf16* WQK, bf16* VWO) {
    const int gw = F.vcu * NWAVES + F.wave, NGW = F.G * NWAVES;
    const float qsx = 0.08838834764831845f * LOG2E;
    for (int T = gw; T < 16384; T += NGW) {
        const int which = T >> 13, t = T & 8191, bh = t >> 8, b = bh >> 2, hd = bh & 3;
        if (which == 0) { const int it = (t >> 5) & 7, jt = t & 31;
            small_tile(KV + (size_t)(b * 256 + it * 32) * 1024 + hd * 128, 1024, WQ + (size_t)(jt * 32) * 512 + hd * 128, 512, qsx, WQK + (size_t)b * DM * DM + (size_t)(hd * 256 + it * 32) * DM + jt * 32, DM, F.lane);
        } else { const int it = (t >> 3) & 31, jt = t & 7;
            small_tile(WOC + (size_t)(it * 32) * 512 + hd * 128, 512, KV + (size_t)(b * 256 + jt * 32) * 1024 + 512 + hd * 128, 1024, 1.0f, VWO + (size_t)b * DM * DM + (size_t)(it * 32) * DM + hd * 256 + jt * 32, DM, F.lane); }
    }
}

__device__ __forceinline__ void xattn_phase(const Frame& F, bf16* QO, const bf16* KV, bf16* OUT = nullptr) {
    if (!OUT) OUT = QO;
    typedef float f32x2v __attribute__((ext_vector_type(2)));
    constexpr int VTP = 260;
    LAS unsigned char* Ks = F.lds;
    LAS bf16* VT = (LAS bf16*)(F.lds + 65536);
    LAS float* lsc = (LAS float*)(F.lds + 65536 + 128 * VTP * 2) + F.wave * 32;
    const int r32 = F.lane & 31, hi = F.lane >> 5;
    for (int item = F.vcu; item < 256; item += F.G) {
        const int bh = item >> 3, b = bh >> 2, hd = bh & 3;
        __syncthreads();
#pragma unroll
        for (int i = 0; i < 8; ++i) { const int c = F.tid + 512 * i, key = c >> 4, ch = c & 15; const bf16* src = KV + (size_t)(b * 256 + key) * 1024 + hd * 128 + ch * 8;
            const v4u kx = *(const GAS v4u*)src; const v4u vx = *(const GAS v4u*)(src + 512);
            *(LAS v4u*)(Ks + key * 256 + ((ch ^ (key & 15)) << 4)) = kx;
            LAS bf16* vt = VT + (ch * 8) * VTP + key;
            vt[0 * VTP] = (bf16)(vx.x & 0xffffu); vt[1 * VTP] = (bf16)(vx.x >> 16); vt[2 * VTP] = (bf16)(vx.y & 0xffffu); vt[3 * VTP] = (bf16)(vx.y >> 16);
            vt[4 * VTP] = (bf16)(vx.z & 0xffffu); vt[5 * VTP] = (bf16)(vx.z >> 16); vt[6 * VTP] = (bf16)(vx.w & 0xffffu); vt[7 * VTP] = (bf16)(vx.w >> 16); }
        LDS_WAIT(); __syncthreads();
        for (int qi = 0; qi < 4; ++qi) {
            const size_t row0 = (size_t)b * SEQ + (size_t)((item & 7) * 4 + qi) * 256 + F.wave * 32;
            bf16* qp = QO + (row0 + r32) * 512 + hd * 128 + hi * 8;
            bf16x8 qf[8];
#pragma unroll
            for (int d0 = 0; d0 < 8; ++d0) qf[d0] = *(const GAS bf16x8*)(qp + d0 * 16);
            f32x16 s[8];
#pragma unroll
            for (int kb = 0; kb < 8; ++kb) { s[kb] = f32x16{}; const int key = kb * 32 + r32;
#pragma unroll
                for (int d0 = 0; d0 < 8; ++d0) { const bf16x8 kf = *(const LAS bf16x8*)(Ks + key * 256 + (((2 * d0 + hi) ^ (key & 15)) << 4)); s[kb] = __builtin_amdgcn_mfma_f32_32x32x16_bf16(kf, qf[d0], s[kb], 0, 0, 0); } }
            float mx = -INFINITY;
#pragma unroll
            for (int kb = 0; kb < 8; ++kb)
#pragma unroll
                for (int r = 0; r < 16; ++r) mx = fmaxf(mx, s[kb][r]);
            mx = fmaxf(mx, __shfl_xor(mx, 32));
            float sum = 0.f;
#pragma unroll
            for (int kb = 0; kb < 8; ++kb)
#pragma unroll
                for (int r = 0; r < 16; ++r) { const float pv_ = __builtin_amdgcn_exp2f(s[kb][r] - mx); s[kb][r] = pv_; sum += pv_; }
            sum += __shfl_xor(sum, 32);
            bf16x8 pa[16];
#pragma unroll
            for (int kb = 0; kb < 8; ++kb)
#pragma unroll
                for (int sp = 0; sp < 2; ++sp) { pg8::u32x4 pw; pw.x = pg8::cvt_pk_bf16(s[kb][8 * sp + 0], s[kb][8 * sp + 1]); pw.y = pg8::cvt_pk_bf16(s[kb][8 * sp + 2], s[kb][8 * sp + 3]); pw.z = pg8::cvt_pk_bf16(s[kb][8 * sp + 4], s[kb][8 * sp + 5]); pw.w = pg8::cvt_pk_bf16(s[kb][8 * sp + 6], s[kb][8 * sp + 7]);
                    pa[kb * 2 + sp] = __builtin_bit_cast(bf16x8, pw); }
            asm volatile("" ::: "memory");
            f32x16 o[4];
#pragma unroll
            for (int db = 0; db < 4; ++db) o[db] = f32x16{};
#pragma unroll
            for (int ks = 0; ks < 16; ++ks) { const int kbase = (ks >> 1) * 32 + 16 * (ks & 1) + 4 * hi;
#pragma unroll
                for (int db = 0; db < 4; ++db) { const LAS bf16* vp = VT + (db * 32 + r32) * VTP + kbase; const v2u lo = *(const LAS v2u*)vp, hi4 = *(const LAS v2u*)(vp + 8);
                    pg8::u32x4 bw; bw.x = lo.x; bw.y = lo.y; bw.z = hi4.x; bw.w = hi4.y; o[db] = __builtin_amdgcn_mfma_f32_32x32x16_bf16(__builtin_bit_cast(bf16x8, bw), pa[ks], o[db], 0, 0, 0); } }
            { const float inv = __builtin_amdgcn_rcpf(sum); bf16* op = OUT + (row0 + r32) * 512 + hd * 128 + 4 * hi;
#pragma unroll
                for (int db = 0; db < 4; ++db)
#pragma unroll
                    for (int rg = 0; rg < 4; ++rg) { v2u w_; w_.x = pg8::cvt_pk_bf16(o[db][4 * rg] * inv, o[db][4 * rg + 1] * inv); w_.y = pg8::cvt_pk_bf16(o[db][4 * rg + 2] * inv, o[db][4 * rg + 3] * inv); *(GAS v2u*)(op + db * 32 + rg * 8) = w_; } }
        }
    }
    __syncthreads();
}

__device__ __forceinline__ void sgu_phase(const Frame& F, bf16* PROJ, const bf16* WS  , const float* gain  , const float* bs  ) {
    LAS float* rs = (LAS float*)(F.lds + RING_OFF);
    LAS bf16* vT = (LAS bf16*)(F.lds + RING_OFF + 1024);
    LAS bf16* oT = vT + 128 * 136;
    constexpr int VP = 136;
    const int r31 = F.lane & 31, hi = F.lane >> 5;
    for (int ch = blockIdx.x; ch < M / 128; ch += F.G) {
        const size_t t0 = (size_t)ch * 128;
        { v4u x[4];
#pragma unroll
            for (int r4 = 0; r4 < 16; r4 += 4) {
#pragma unroll
                for (int q = 0; q < 4; ++q) x[q] = *(const GAS v4u*)(PROJ + (t0 + F.wave * 16 + r4 + q) * PP + C_AV + F.lane * 8);
#pragma unroll
                for (int q = 0; q < 4; ++q) { float s = bflo(x[q].x) * bflo(x[q].x) + bfhi(x[q].x) * bfhi(x[q].x) + bflo(x[q].y) * bflo(x[q].y) + bfhi(x[q].y) * bfhi(x[q].y) + bflo(x[q].z) * bflo(x[q].z) + bfhi(x[q].z) * bfhi(x[q].z) + bflo(x[q].w) * bflo(x[q].w) + bfhi(x[q].w) * bfhi(x[q].w);
                    s = wave_sum(s); if (F.lane == 0) rs[F.wave * 16 + r4 + q] = 1.f / sqrtf(s * (1.f / 512.f) + EPS); } } }
        LDS_WAIT(); __syncthreads();
        v4u x[4];
#pragma unroll
        for (int i = 0; i < 4; ++i) { const int q = F.tid + 512 * i, s = q >> 4, dc = (q & 15) * 8; x[i] = *(const GAS v4u*)(PROJ + (t0 + s) * PP + C_AV + dc); }
#pragma unroll 1
        for (int g = 0; g < 4; ++g) {
            v4u uu[4], xn[4];
#pragma unroll
            for (int i = 0; i < 4; ++i) { const int q = F.tid + 512 * i, t = q >> 4, dc = (q & 15) * 8; uu[i] = *(const GAS v4u*)(PROJ + (t0 + t) * PP + C_AU + g * 128 + dc); }
            { const int gn = g < 3 ? g + 1 : 3;
#pragma unroll
                for (int i = 0; i < 4; ++i) { const int q = F.tid + 512 * i, s = q >> 4, dc = (q & 15) * 8; xn[i] = *(const GAS v4u*)(PROJ + (t0 + s) * PP + C_AV + gn * 128 + dc); } }
            {
#pragma unroll
                for (int i = 0; i < 4; ++i) { const int q = F.tid + 512 * i, s = q >> 4, dc = (q & 15) * 8; const float r = rs[s]; const f32x4 g0 = *(const GAS f32x4*)(gain + g * 128 + dc), g1 = *(const GAS f32x4*)(gain + g * 128 + dc + 4);
                    vT[(dc + 0) * VP + s] = (bf16)f2bf(bflo(x[i].x) * r * g0[0]); vT[(dc + 1) * VP + s] = (bf16)f2bf(bfhi(x[i].x) * r * g0[1]); vT[(dc + 2) * VP + s] = (bf16)f2bf(bflo(x[i].y) * r * g0[2]); vT[(dc + 3) * VP + s] = (bf16)f2bf(bfhi(x[i].y) * r * g0[3]);
                    vT[(dc + 4) * VP + s] = (bf16)f2bf(bflo(x[i].z) * r * g1[0]); vT[(dc + 5) * VP + s] = (bf16)f2bf(bfhi(x[i].z) * r * g1[1]); vT[(dc + 6) * VP + s] = (bf16)f2bf(bflo(x[i].w) * r * g1[2]); vT[(dc + 7) * VP + s] = (bf16)f2bf(bfhi(x[i].w) * r * g1[3]); } }
            const int tt = F.wave >> 1; const bf16* wg = WS + (size_t)g * 128 * 128 + (size_t)(tt * 32 + r31) * 128 + 8 * hi;
            bf16x8 av[8];
#pragma unroll
            for (int ks = 0; ks < 8; ++ks) if (ks <= 2 * tt + 1) av[ks] = *(const GAS bf16x8*)(wg + ks * 16);
            LDS_WAIT(); __syncthreads();
#pragma unroll
            for (int dq = 0; dq < 2; ++dq) { const int dd = (F.wave & 1) * 2 + dq; f32x16 acc = {};
#pragma unroll
                for (int ks = 0; ks < 8; ++ks) if (ks <= 2 * tt + 1) { const bf16x8 bv = *(const LAS bf16x8*)(vT + (dd * 32 + r31) * VP + ks * 16 + 8 * hi);
                    acc = __builtin_amdgcn_mfma_f32_32x32x16_bf16(av[ks], bv, acc, 0, 0, 0); }
#pragma unroll
                for (int r = 0; r < 16; ++r) { const int t = tt * 32 + (r & 3) + 8 * (r >> 2) + 4 * hi; oT[t * VP + dd * 32 + r31] = (bf16)f2bf(acc[r] + bs[g * 128 + t]); } }
            LDS_WAIT(); __syncthreads();
#pragma unroll
            for (int i = 0; i < 4; ++i) { const int q = F.tid + 512 * i, t = q >> 4, dc = (q & 15) * 8; bf16* up = PROJ + (t0 + t) * PP + C_AU + g * 128 + dc;
                const v4u u = uu[i]; const v4u m = *(const LAS v4u*)(oT + t * VP + dc); v4u o;
                o.x = pk2(bflo(u.x) * bflo(m.x), bfhi(u.x) * bfhi(m.x)); o.y = pk2(bflo(u.y) * bflo(m.y), bfhi(u.y) * bfhi(m.y)); o.z = pk2(bflo(u.z) * bflo(m.z), bfhi(u.z) * bfhi(m.z)); o.w = pk2(bflo(u.w) * bflo(m.w), bfhi(u.w) * bfhi(m.w));
                *(GAS v4u*)up = o; }
#pragma unroll
            for (int i = 0; i < 4; ++i) x[i] = xn[i];
        }
        LDS_WAIT(); __syncthreads();
    }
}

__device__ __forceinline__ void lru_gate_phase(const Frame& F, const bf16* XC, const bf16* W  , bf16* PROJ, const float* ba, const float* bx, const float* lam, float* LA, float* LH, float* LA8, float* LH8) {
    const int r31 = F.lane & 31, hi = F.lane >> 5;
    LAS bf16* so = (LAS bf16*)(F.lds + RING_OFF) + F.wave * 8192;
    LAS bf16* sg = so + 4096;
#pragma unroll 1
    for (int c = blockIdx.x; c < M / 256; c += F.G) {
        const size_t r0 = (size_t)c * 256 + F.wave * 32;
#pragma unroll 1
        for (int h = 0; h < 4; ++h) {
            bf16x8 af[8];
#pragma unroll
            for (int ks = 0; ks < 8; ++ks) af[ks] = *(const GAS bf16x8*)(XC + (r0 + r31) * 512 + h * 128 + ks * 16 + 8 * hi);
#pragma unroll 1
            for (int j = 0; j < 4; ++j) {
                const bf16* wr = W + (size_t)(h * 256 + j * 32 + r31) * 128 + 8 * hi; f32x16 ar = {}, ai = {};
                bf16x8 b0[8], b1[8];
#pragma unroll
                for (int ks = 0; ks < 8; ++ks) { b0[ks] = *(const GAS bf16x8*)(wr + ks * 16); b1[ks] = *(const GAS bf16x8*)(wr + 128 * 128 + ks * 16); }
#pragma unroll
                for (int ks = 0; ks < 8; ++ks) { ar = __builtin_amdgcn_mfma_f32_32x32x16_bf16(af[ks], b0[ks], ar, 0, 0, 0); ai = __builtin_amdgcn_mfma_f32_32x32x16_bf16(af[ks], b1[ks], ai, 0, 0, 0); }
                const int chl = j * 32 + r31, ch = h * 128 + chl; const float bav = ba[ch], bxv = bx[ch], sp = -8.0f * LOG2E * log1pf(__expf(-lam[ch]));
#pragma unroll
                for (int r = 0; r < 16; ++r) { const int rl = (r & 3) + 8 * (r >> 2) + 4 * hi;
                    const float rg = pg8::fast_sigmoid(ar[r] + bav), ig = pg8::fast_sigmoid(ai[r] + bxv); const float a = __builtin_amdgcn_exp2f(rg * sp); const float om = 1.0f - a;
                    so[rl * 128 + chl] = (bf16)f2bf(om); sg[rl * 128 + chl] = (bf16)f2bf(ig * __builtin_sqrtf(om * (1.0f + a))); }
            }
            LDS_WAIT();
            { float A8[8], H8[8]; const int cc = (F.lane & 15) * 8, rb = (F.lane >> 4) * 8;
#pragma unroll
                for (int j = 0; j < 8; ++j) { A8[j] = 1.f; H8[j] = 0.f; }
#pragma unroll
                for (int q8 = 0; q8 < 8; ++q8) { const int rl = rb + q8; const size_t row = r0 + rl;
                    const v4u x = *(const GAS v4u*)(XC + row * 512 + h * 128 + cc); const v4u o = *(const LAS v4u*)(so + rl * 128 + cc); const v4u g = *(const LAS v4u*)(sg + rl * 128 + cc); v4u y;
                    y.x = pk2(bflo(x.x) * bflo(g.x), bfhi(x.x) * bfhi(g.x)); y.y = pk2(bflo(x.y) * bflo(g.y), bfhi(x.y) * bfhi(g.y)); y.z = pk2(bflo(x.z) * bflo(g.z), bfhi(x.z) * bfhi(g.z)); y.w = pk2(bflo(x.w) * bflo(g.w), bfhi(x.w) * bfhi(g.w));
                    *(GAS v4u*)(PROJ + row * PP + C_OM + h * 128 + cc) = o; *(GAS v4u*)(PROJ + row * PP + C_INP + h * 128 + cc) = y;
                    const float av[8] = {1.f - bflo(o.x), 1.f - bfhi(o.x), 1.f - bflo(o.y), 1.f - bfhi(o.y), 1.f - bflo(o.z), 1.f - bfhi(o.z), 1.f - bflo(o.w), 1.f - bfhi(o.w)};
                    const float iv[8] = {bflo(y.x), bfhi(y.x), bflo(y.y), bfhi(y.y), bflo(y.z), bfhi(y.z), bflo(y.w), bfhi(y.w)};
#pragma unroll
                    for (int j = 0; j < 8; ++j) { H8[j] = av[j] * H8[j] + iv[j]; A8[j] *= av[j]; } }
#pragma unroll
                for (int st = 16; st <= 32; st <<= 1) { const bool early = (F.lane & st) == 0;
#pragma unroll
                    for (int j = 0; j < 8; ++j) { const float Ap = __shfl_xor(A8[j], st), Hp = __shfl_xor(H8[j], st);
                        const float Ae = early ? A8[j] : Ap, He = early ? H8[j] : Hp, Al = early ? Ap : A8[j], Hl = early ? Hp : H8[j];
                        A8[j] = Ae * Al; H8[j] = Al * He + Hl; } }
                if ((F.lane >> 4) == 0) { float* ga = LA8 + ((size_t)c * 8 + F.wave) * 512 + h * 128 + cc; float* gh = LH8 + ((size_t)c * 8 + F.wave) * 512 + h * 128 + cc;
                    *(GAS f32x4*)ga = (f32x4){A8[0], A8[1], A8[2], A8[3]}; *(GAS f32x4*)(ga + 4) = (f32x4){A8[4], A8[5], A8[6], A8[7]};
                    *(GAS f32x4*)gh = (f32x4){H8[0], H8[1], H8[2], H8[3]}; *(GAS f32x4*)(gh + 4) = (f32x4){H8[4], H8[5], H8[6], H8[7]}; } }
            LDS_WAIT();
        }
        __syncthreads();
        { float a = 1.f, hq = 0.f;
#pragma unroll
            for (int w = 0; w < 8; ++w) { const float aw = LA8[((size_t)c * 8 + w) * 512 + F.tid], hw = LH8[((size_t)c * 8 + w) * 512 + F.tid]; hq = aw * hq + hw; a *= aw; }
            LA[c * 512 + F.tid] = a; LH[c * 512 + F.tid] = hq; }
        __syncthreads();
    }
}

__device__ __forceinline__ void lru_pass1(const Frame& F, const bf16* PROJ, float* LA, float* LH, float* LA8, float* LH8) {
    LAS float* sA = (LAS float*)(F.lds + RING_OFF);
    LAS float* sH = sA + 8 * 512;
    for (int c = blockIdx.x; c < M / 256; c += F.G) {
        const bf16* p = PROJ + ((size_t)c * 256 + F.wave * 32) * PP + F.lane * 8;
        float A[8], hh[8];
#pragma unroll
        for (int j = 0; j < 8; ++j) { A[j] = 1.f; hh[j] = 0.f; }
#pragma unroll 8
        for (int t = 0; t < 32; ++t) { const v4u o = *(const GAS v4u*)(p + (size_t)t * PP + C_OM); const v4u x = *(const GAS v4u*)(p + (size_t)t * PP + C_INP);
            const float av[8] = {1.f - bflo(o.x), 1.f - bfhi(o.x), 1.f - bflo(o.y), 1.f - bfhi(o.y), 1.f - bflo(o.z), 1.f - bfhi(o.z), 1.f - bflo(o.w), 1.f - bfhi(o.w)};
            const float iv[8] = {bflo(x.x), bfhi(x.x), bflo(x.y), bfhi(x.y), bflo(x.z), bfhi(x.z), bflo(x.w), bfhi(x.w)};
#pragma unroll
            for (int j = 0; j < 8; ++j) { hh[j] = av[j] * hh[j] + iv[j]; A[j] *= av[j]; } }
        { float* ga = LA8 + ((size_t)c * 8 + F.wave) * 512 + F.lane * 8; float* gh = LH8 + ((size_t)c * 8 + F.wave) * 512 + F.lane * 8;
            *(GAS f32x4*)ga = (f32x4){A[0], A[1], A[2], A[3]}; *(GAS f32x4*)(ga + 4) = (f32x4){A[4], A[5], A[6], A[7]};
            *(GAS f32x4*)gh = (f32x4){hh[0], hh[1], hh[2], hh[3]}; *(GAS f32x4*)(gh + 4) = (f32x4){hh[4], hh[5], hh[6], hh[7]};
#pragma unroll
            for (int j = 0; j < 8; ++j) { sA[F.wave * 512 + F.lane * 8 + j] = A[j]; sH[F.wave * 512 + F.lane * 8 + j] = hh[j]; } }
        LDS_WAIT(); __syncthreads();
        { float a = 1.f, h = 0.f;
#pragma unroll
            for (int w = 0; w < 8; ++w) { const float aw = sA[w * 512 + F.tid], hw = sH[w * 512 + F.tid]; h = aw * h + hw; a *= aw; }
            LA[c * 512 + F.tid] = a; LH[c * 512 + F.tid] = h; }
        LDS_WAIT(); __syncthreads();
    }
}
__device__ __forceinline__ void lru_pass2(const Frame& F, bf16* PROJ, const float* LA, const float* LH, const float* LA8, const float* LH8) {
    LAS float* sC = (LAS float*)(F.lds + RING_OFF);
    for (int c = blockIdx.x; c < M / 256; c += F.G) {
        { float hc = 0.f; const int cb = c & ~31, nprev = c - cb;
            float wa[8], wh[8];
#pragma unroll
            for (int w = 0; w < 8; ++w) { wa[w] = LA8[((size_t)c * 8 + w) * 512 + F.tid]; wh[w] = LH8[((size_t)c * 8 + w) * 512 + F.tid]; }
            float la[32], lh[32];
#pragma unroll
            for (int q = 0; q < 32; ++q) { const bool ok = q < nprev; const int c2 = ok ? cb + q : c; la[q] = LA[c2 * 512 + F.tid]; lh[q] = LH[c2 * 512 + F.tid]; if (!ok) { la[q] = 1.0f; lh[q] = 0.0f; } }
#pragma unroll
            for (int q = 0; q < 32; ++q) hc = la[q] * hc + lh[q];
#pragma unroll
            for (int w = 0; w < 8; ++w) { sC[w * 512 + F.tid] = hc; hc = wa[w] * hc + wh[w]; } }
        LDS_WAIT(); __syncthreads();
        bf16* p = PROJ + ((size_t)c * 256 + F.wave * 32) * PP + F.lane * 8;
        float hh[8];
#pragma unroll
        for (int j = 0; j < 8; ++j) hh[j] = sC[F.wave * 512 + F.lane * 8 + j];
#pragma unroll 8
        for (int t = 0; t < 32; ++t) { const v4u o = *(const GAS v4u*)(p + (size_t)t * PP + C_OM); const v4u x = *(const GAS v4u*)(p + (size_t)t * PP + C_INP); const v4u y = *(const GAS v4u*)(p + (size_t)t * PP + C_BY);
            const float av[8] = {1.f - bflo(o.x), 1.f - bfhi(o.x), 1.f - bflo(o.y), 1.f - bfhi(o.y), 1.f - bflo(o.z), 1.f - bfhi(o.z), 1.f - bflo(o.w), 1.f - bfhi(o.w)};
            const float iv[8] = {bflo(x.x), bfhi(x.x), bflo(x.y), bfhi(x.y), bflo(x.z), bfhi(x.z), bflo(x.w), bfhi(x.w)};
            const float yv[8] = {bflo(y.x), bfhi(y.x), bflo(y.y), bfhi(y.y), bflo(y.z), bfhi(y.z), bflo(y.w), bfhi(y.w)};
#pragma unroll
            for (int j = 0; j < 8; ++j) hh[j] = av[j] * hh[j] + iv[j];
            v4u r; r.x = pk2(hh[0] * yv[0], hh[1] * yv[1]); r.y = pk2(hh[2] * yv[2], hh[3] * yv[3]); r.z = pk2(hh[4] * yv[4], hh[5] * yv[5]); r.w = pk2(hh[6] * yv[6], hh[7] * yv[7]);
            *(GAS v4u*)(p + (size_t)t * PP + C_BY) = r; }
        LDS_WAIT(); __syncthreads();
    }
}

__device__ __forceinline__ void swa_phase(const Frame& F, bf16* PROJ, const float* sinks  ) {
    constexpr int VTP = 388;
    LAS unsigned char* Ks = F.lds;
    LAS bf16* VT = (LAS bf16*)(F.lds + 49152);
    LAS float* lsc = (LAS float*)(F.lds + 49152 + 64 * VTP * 2) + F.wave * 32;
    const int r32 = F.lane & 31, hi = F.lane >> 5;
#pragma unroll 1
    for (int unit = F.vcu; unit < 512; unit += F.G) {
        const int qb = unit & 31, bk = unit >> 5, b = bk >> 1, kvh = bk & 1;
        const long q0 = (long)b * SEQ + (long)qb * 256;
        __syncthreads();
#pragma unroll
        for (int i = 0; i < 6; ++i) { const int c = F.tid + 512 * i, key = c >> 3, ch = c & 7; v4u kx = (v4u){0u, 0u, 0u, 0u}, vx = kx;
            if (qb > 0 || key >= 128) { const bf16* src = PROJ + (size_t)(q0 - 128 + key) * PP + C_CK + kvh * 64 + ch * 8; kx = *(const GAS v4u*)src; vx = *(const GAS v4u*)(src + (C_CV - C_CK)); }
            *(LAS v4u*)(Ks + key * 128 + ((ch ^ (key & 7)) << 4)) = kx;
            LAS bf16* vt = VT + (ch * 8) * VTP + key;
            vt[0 * VTP] = (bf16)(vx.x & 0xffffu); vt[1 * VTP] = (bf16)(vx.x >> 16); vt[2 * VTP] = (bf16)(vx.y & 0xffffu); vt[3 * VTP] = (bf16)(vx.y >> 16);
            vt[4 * VTP] = (bf16)(vx.z & 0xffffu); vt[5 * VTP] = (bf16)(vx.z >> 16); vt[6 * VTP] = (bf16)(vx.w & 0xffffu); vt[7 * VTP] = (bf16)(vx.w >> 16); }
        LDS_WAIT(); __syncthreads();
        const int kw0 = F.wave * 32;
#pragma unroll 1
        for (int g = 0; g < 4; ++g) {
            const int hd = kvh * 4 + g; const float slope2 = exp2f(-(float)(hd + 1)) * LOG2E, sink2 = sinks[hd] * LOG2E;
            bf16* qp = PROJ + (size_t)(q0 + kw0 + r32) * PP + C_CQ + hd * 64 + hi * 8;
            bf16x8 qf[4];
#pragma unroll
            for (int d0 = 0; d0 < 4; ++d0) qf[d0] = *(const GAS bf16x8*)(qp + d0 * 16);
            f32x16 s[5];
#pragma unroll
            for (int kb = 0; kb < 5; ++kb) { s[kb] = f32x16{}; const int key = kw0 + kb * 32 + r32;
#pragma unroll
                for (int d0 = 0; d0 < 4; ++d0) { const bf16x8 kf = *(const LAS bf16x8*)(Ks + key * 128 + (((2 * d0 + hi) ^ (key & 7)) << 4)); s[kb] = __builtin_amdgcn_mfma_f32_32x32x16_bf16(kf, qf[d0], s[kb], 0, 0, 0); } }
            const int dl0 = 4 * hi - r32;
            const int kmin = (qb > 0) ? -1000000 : 128 - (kw0 + 4 * hi);
            float mx = sink2;
#pragma unroll
            for (int kb = 0; kb < 5; ++kb)
#pragma unroll
                for (int r = 0; r < 16; ++r) { const int c = kb * 32 + (r & 3) + 8 * (r >> 2); const int d = dl0 + c; const bool ok = ((unsigned)(d - 1) < 128u) && (c >= kmin);
                    float v = ok ? s[kb][r] - slope2 * (float)(128 - d) : -INFINITY; asm volatile("" : "+v"(v));     s[kb][r] = v; mx = fmaxf(mx, v); }
            mx = fmaxf(mx, __shfl_xor(mx, 32));
            float sum = 0.f;
#pragma unroll
            for (int kb = 0; kb < 5; ++kb)
#pragma unroll
                for (int r = 0; r < 16; ++r) { const float pv_ = __builtin_amdgcn_exp2f(s[kb][r] - mx); s[kb][r] = pv_; sum += pv_; }
            sum += __shfl_xor(sum, 32); sum += __builtin_amdgcn_exp2f(sink2 - mx);
            bf16x8 pa[10];
#pragma unroll
            for (int kb = 0; kb < 5; ++kb)
#pragma unroll
                for (int sp = 0; sp < 2; ++sp) { pg8::u32x4 pw; pw.x = pg8::cvt_pk_bf16(s[kb][8 * sp + 0], s[kb][8 * sp + 1]); pw.y = pg8::cvt_pk_bf16(s[kb][8 * sp + 2], s[kb][8 * sp + 3]); pw.z = pg8::cvt_pk_bf16(s[kb][8 * sp + 4], s[kb][8 * sp + 5]); pw.w = pg8::cvt_pk_bf16(s[kb][8 * sp + 6], s[kb][8 * sp + 7]);
                    pa[kb * 2 + sp] = __builtin_bit_cast(bf16x8, pw); }
            asm volatile("" ::: "memory");
            f32x16 o[2];
            o[0] = f32x16{}; o[1] = f32x16{};
#pragma unroll
            for (int ks = 0; ks < 10; ++ks) { const int kbase = kw0 + (ks >> 1) * 32 + 16 * (ks & 1) + 4 * hi;
#pragma unroll
                for (int db = 0; db < 2; ++db) { const LAS bf16* vp = VT + (db * 32 + r32) * VTP + kbase; const v2u lo = *(const LAS v2u*)vp, hi4 = *(const LAS v2u*)(vp + 8);
                    pg8::u32x4 bw; bw.x = lo.x; bw.y = lo.y; bw.z = hi4.x; bw.w = hi4.y; o[db] = __builtin_amdgcn_mfma_f32_32x32x16_bf16(__builtin_bit_cast(bf16x8, bw), pa[ks], o[db], 0, 0, 0); } }
            { const float inv = __builtin_amdgcn_rcpf(sum); bf16* op = PROJ + (size_t)(q0 + kw0 + r32) * PP + C_CQ + hd * 64 + 4 * hi;
#pragma unroll
                for (int db = 0; db < 2; ++db)
#pragma unroll
                    for (int rg = 0; rg < 4; ++rg) { v2u w_; w_.x = pg8::cvt_pk_bf16(o[db][4 * rg] * inv, o[db][4 * rg + 1] * inv); w_.y = pg8::cvt_pk_bf16(o[db][4 * rg + 2] * inv, o[db][4 * rg + 3] * inv); *(GAS v2u*)(op + db * 32 + rg * 8) = w_; } }
        }
    }
    __syncthreads();
}

__device__ __forceinline__ float wave_max(float v) {
#pragma unroll
    for (int o = 1; o < 64; o <<= 1) v = fmaxf(v, __shfl_xor(v, o));
    return v;
}
__device__ __forceinline__ void fox_bounds_phase(const Frame& F, const bf16* PROJ, float* KN, float* QN) {
    const int gw = F.vcu * NWAVES + F.wave, NGW = F.G * NWAVES, q = F.lane & 7, rsub = F.lane >> 3;
    for (int it = gw; it < 64 * 128 + 64 * 32; it += NGW) {
        const bool isk = it < 64 * 128; const int i2 = isk ? it : it - 64 * 128; const int bh = isk ? (i2 >> 7) : (i2 >> 5), blk = isk ? (i2 & 127) : (i2 & 31), b = bh >> 3, hd = bh & 7;
        const int npass = isk ? 8 : 32; const size_t row0 = (size_t)b * SEQ + (isk ? blk * 64 : blk * 256); const bf16* base = PROJ + row0 * PP + (isk ? C_DK : C_DQ) + hd * 64 + q * 8; float mx = 0.f;
#pragma unroll 8
        for (int ps = 0; ps < npass; ++ps) { const v4u x = *(const GAS v4u*)(base + (size_t)(ps * 8 + rsub) * PP);
            float ss = (bflo(x.x) * bflo(x.x) + bfhi(x.x) * bfhi(x.x)) + (bflo(x.y) * bflo(x.y) + bfhi(x.y) * bfhi(x.y)) + (bflo(x.z) * bflo(x.z) + bfhi(x.z) * bfhi(x.z)) + (bflo(x.w) * bflo(x.w) + bfhi(x.w) * bfhi(x.w));
            ss += __shfl_xor(ss, 1); ss += __shfl_xor(ss, 2); ss += __shfl_xor(ss, 4);
            mx = fmaxf(mx, ss); }
        mx = wave_max(mx);
        if (F.lane == 0) (isk ? KN : QN)[i2] = sqrtf(mx) * 1.001f + 1e-3f;
    }
}
__device__ __forceinline__ void fox_cum_phase(const Frame& F, const float* LC, const float* TOT, float* CUMT) {
    const int gw = F.vcu * NWAVES + F.wave, NGW = F.G * NWAVES;
    for (int it = gw; it < 64 * 32; it += NGW) { const int bh = it >> 5, ck = it & 31, b = bh >> 3, hd = bh & 7;
        float tv = (F.lane < ck) ? TOT[(size_t)(b * 32 + F.lane) * 8 + hd] : 0.f; tv = wave_sum(tv);
#pragma unroll
        for (int q = 0; q < 4; ++q) { const int t = ck * 256 + q * 64 + F.lane; CUMT[(size_t)bh * SEQ + t] = LC[((size_t)b * SEQ + t) * 8 + hd] + tv; } }
}
__device__ __forceinline__ void fox_plan_phase(const Frame& F, const float* CUMT, const float* KN, const float* QN, int* TLO) {
    const int gw = F.vcu * NWAVES + F.wave, NGW = F.G * NWAVES;
    for (int it = gw; it < 64 * 32; it += NGW) { const int bh = it >> 5, qb = it & 31, NTf = 4 * qb + 4;
        const int t0 = F.lane, t1 = F.lane + 64; float kn = fmaxf(t0 < NTf ? KN[bh * 128 + t0] : 0.f, t1 < NTf ? KN[bh * 128 + t1] : 0.f); kn = wave_max(kn);
        const float bnd = QN[it] * kn + CUMT[(size_t)bh * SEQ + qb * 256];
        const bool d0 = (t0 < NTf) && (bnd - CUMT[(size_t)bh * SEQ + 64 * t0 + 63] < -160.0f), d1 = (t1 < NTf) && (bnd - CUMT[(size_t)bh * SEQ + 64 * t1 + 63] < -160.0f);
        int tlo = (__popcll(__ballot(d0)) + __popcll(__ballot(d1))) & ~1; tlo = tlo > NTf - 4 ? NTf - 4 : tlo;
        if (F.lane == 0) TLO[it] = tlo; }
}
__device__ __forceinline__ int attn_phase(const Frame& F, char* lds_generic, bf16* PROJ, const float* CUMT, const int* TLO, unsigned* qctr, int first = -1, int uoff = 0) {
    using attn_body::attn_unit;
    typedef __hip_bfloat16 hb;
    LAS float* ckl = (LAS float*)(F.lds + CKL_OFF);
    LAS int* sh = (LAS int*)(ckl + 8192 + 64);
    for (bool have = first >= 0;; have = false) {
        int tid = threadIdx.x; asm volatile("" : "+v"(tid));
        int tk = first;
        if (!have) {
            if (tid == 0) sh[0] = (int)__hip_atomic_fetch_add(qctr, 1u, RLX_AGENT);
            LDS_WAIT(); __syncthreads();
            tk = __builtin_amdgcn_readfirstlane(sh[0]); }
        const int u = tk - uoff;
        if (u >= 2048) { __syncthreads(); return tk; }
        {
            const int qb = 31 - (u >> 6), bh = u & 63, b = bh >> 3, hd = bh & 7, NTf = 4 * qb + 4;
            const int tlo = __builtin_amdgcn_readfirstlane(TLO[bh * 32 + qb]);
            const int nfill = qb * 256 + 256 - 64 * tlo; const float* cs = CUMT + (size_t)bh * SEQ + 64 * tlo;
            for (int i = tid; i < nfill; i += NWAVES * 64) ckl[i] = cs[i];
            LDS_WAIT(); __syncthreads();
            const size_t q0 = (size_t)b * SEQ + (size_t)qb * 256, k0 = (size_t)b * SEQ + (size_t)tlo * 64;
            attn_unit<8, 0>((const hb*)(PROJ + q0 * PP + C_DQ + hd * 64), (const hb*)(PROJ + k0 * PP + C_DK + hd * 64), (const hb*)(PROJ + k0 * PP + C_DV + hd * 64), (hb*)(PROJ + q0 * PP + C_DQ + hd * 64),
                            NTf - tlo, 0, ckl, qb * 256 - 64 * tlo, -INFINITY, 0.f, lds_generic);
        }
    }
}
__device__ __forceinline__ int attn_queue_next(const Frame& F, unsigned* qctr) {
    LAS int* sh = (LAS int*)((LAS float*)(F.lds + CKL_OFF) + 8192 + 64);
    __syncthreads();
    if (F.tid == 0) sh[0] = (int)__hip_atomic_fetch_add(qctr, 1u, RLX_AGENT);
    LDS_WAIT(); __syncthreads();
    const int u = __builtin_amdgcn_readfirstlane(sh[0]);
    __syncthreads();
    return u;
}

__device__ __forceinline__ void moe_build_phase(const Frame& F, unsigned char* ws) {
    LAS int* sb = (LAS int*)(F.lds + RING_OFF);
    const int* gcnt = (const int*)(ws + WS_CTL) + CW_MOECNT; const int* wgc = (const int*)(ws + WS_MOE + MOE_WGCNT);
    int* s2t = (int*)(ws + WS_MOE + MOE_S2T); float* sw = (float*)(ws + WS_MOE + MOE_SW); int* tile_e = (int*)(ws + WS_MOE + MOE_TILE_E); int* ntl = (int*)(ws + WS_MOE + MOE_NT);
    for (int c = blockIdx.x; c < M / 256; c += F.G) {
        if (F.tid < 16) sb[16 + F.tid] = __hip_atomic_load(gcnt + F.tid, RLX_AGENT);
        { const int ke = F.tid & 15, part = F.tid >> 4; int p = 0;
#pragma unroll
            for (int q = 0; q < 8; ++q) { const int c2 = part * 8 + q; if (c2 < c) p += wgc[c2 * 16 + ke]; }
            sb[1100 + F.tid] = p; }
        if (F.tid < 256) { const v4u r = *(const GAS v4u*)(ws + WS_ROUTE + ((size_t)c * 256 + F.tid) * 16); sb[64 + F.tid * 2] = (int)r.x; sb[64 + F.tid * 2 + 1] = (int)r.y; sb[576 + F.tid * 2] = (int)r.z; sb[576 + F.tid * 2 + 1] = (int)r.w; }
        LDS_WAIT(); __syncthreads();
        if (F.tid < 16) { int p = 0; for (int part = 0; part < 32; ++part) p += sb[1100 + part * 16 + F.tid]; sb[32 + F.tid] = p; }
        if (F.tid < 2) { int run = 0; for (int e = 0; e < 8; ++e) { sb[F.tid * 8 + e] = run; run += (sb[16 + F.tid * 8 + e] + 255) & ~255; } if (c == 0) ntl[F.tid] = run >> 8; }
        int e_[2] = {0, 0}, rk_[2] = {0, 0};
        if (F.tid < 256) {
#pragma unroll
            for (int k = 0; k < 2; ++k) { const int e = sb[64 + F.tid * 2 + k]; e_[k] = e;
#pragma unroll
                for (int e2 = 0; e2 < 8; ++e2) { const unsigned long long m = __ballot(e == e2); if (e == e2) rk_[k] = __popcll(m & ((1ull << F.lane) - 1ull)); if (F.lane == 0) sb[1700 + (k * 4 + F.wave) * 8 + e2] = __popcll(m); } }
        }
        LDS_WAIT(); __syncthreads();
        if (F.tid < 256) {
#pragma unroll
            for (int k = 0; k < 2; ++k) { const int e = e_[k], ke = k * 8 + e; int slot = sb[ke] + sb[32 + ke] + rk_[k]; for (int w = 0; w < F.wave; ++w) slot += sb[1700 + (k * 4 + w) * 8 + e];
                s2t[(size_t)k * SLOTS + slot] = c * 256 + F.tid; sw[(size_t)k * SLOTS + slot] = __int_as_float(sb[576 + F.tid * 2 + k]); }
        }
        if (c == 0) {
            for (int q = F.tid; q < 16 * 256; q += NWAVES * 64) { const int ke = q >> 8, i = q & 255, k = ke >> 3; const int tot = sb[16 + ke], pad = ((tot + 255) & ~255) - tot; if (i < pad) { s2t[(size_t)k * SLOTS + sb[ke] + tot + i] = -1; sw[(size_t)k * SLOTS + sb[ke] + tot + i] = 0.f; }
                const int nt = (tot + 255) >> 8; if (i < nt) tile_e[k * 512 + (sb[ke] >> 8) + i] = ke & 7; } }
        LDS_WAIT(); __syncthreads();
    }
}
__device__ __forceinline__ void moe_gather_phase(const Frame& F, unsigned char* ws, int k) {
    const int gw = F.vcu * NWAVES + F.wave, NGW = F.G * NWAVES;
    const int rows = ((const int*)(ws + WS_MOE + MOE_NT))[k] * 256; const int* s2t = (const int*)(ws + WS_MOE + MOE_S2T) + (size_t)k * SLOTS;
    for (int sl = gw; sl < rows; sl += NGW) { const int tok = s2t[sl]; v4u a = (v4u){0u, 0u, 0u, 0u}, b = a;
        if (tok >= 0) { const GAS v4u* src = (const GAS v4u*)(ws + WS_XN + (size_t)tok * DM * 2); a = src[F.lane]; b = src[64 + F.lane]; }
        GAS v4u* dst = (GAS v4u*)(ws + WS_XG + (size_t)sl * DM * 2); dst[F.lane] = a; dst[64 + F.lane] = b; }
}
__device__ __forceinline__ void final_norm_phase(const Frame& F, const bf16* h, float* out, const float* gain, const unsigned* tmo) {
    const float bad = (__hip_atomic_load(tmo, RLX_AGENT) != 0u) ? 1e15f : 1.0f;
    const int gw = F.vcu * NWAVES + F.wave, NGW = F.G * NWAVES;
    f32x4 g4[4];
#pragma unroll
    for (int j = 0; j < 4; ++j) g4[j] = ((const GAS f32x4*)gain)[F.lane + 64 * j];
    for (int row = gw; row < M; row += NGW) { const GAS v2u* xr = (const GAS v2u*)(h + (size_t)row * DM) + F.lane; GAS f32x4* orow = (GAS f32x4*)(out + (size_t)row * DM) + F.lane; f32x4 v[4]; float s = 0.f;
#pragma unroll
        for (int j = 0; j < 4; ++j) { const v2u w = xr[64 * j]; v[j] = (f32x4){bflo(w.x), bfhi(w.x), bflo(w.y), bfhi(w.y)}; s += (v[j].x * v[j].x + v[j].y * v[j].y) + (v[j].z * v[j].z + v[j].w * v[j].w); }
        const float rstd = 1.f / sqrtf(wave_sum(s) * (1.f / DM) + EPS);
        float keep = 1.0f;
#ifdef MK_ZERO_EXPR
        { const int t = row & (SEQ - 1), b = row >> 13; (void)t; (void)b; if (MK_ZERO_EXPR) keep = 0.f; }
#endif
#pragma unroll
        for (int j = 0; j < 4; ++j) orow[64 * j] = v[j] * (rstd * bad * keep) * g4[j]; }
}
constexpr int NPH = 28;
constexpr int PH_LAYER0 = 2;
constexpr int PH_FINAL = PH_LAYER0 + DEPTH * NPH, PH_TOTAL = PH_FINAL + 1;

typedef const __attribute__((address_space(4))) Args* CArgs;
__device__ __forceinline__ CArgs get_args() { CArgs p = (CArgs)__builtin_amdgcn_kernarg_segment_ptr(); asm volatile("" : "+s"(p)); return p; }
__device__ __forceinline__ Frame make_frame(LAS unsigned char* ldsp) {
    Frame F; int tid = threadIdx.x; asm volatile("" : "+v"(tid));
    F.lds = ldsp; F.tid = tid; F.lane = tid & 63; F.wave = __builtin_amdgcn_readfirstlane(tid >> 6);
    F.G = gridDim.x; { const int bx = blockIdx.x; F.vcu = (F.G % 8 == 0) ? (bx % 8) * (F.G / 8) + bx / 8 : bx; }
    return F;
}
__device__ __forceinline__ bool ph_in(int k) { CArgs a = get_args(); return a->ph_lo <= k && k < a->ph_hi; }
__device__ __forceinline__ void seam(int nextk, LAS unsigned char* ldsp) {
    CArgs a = get_args();
    if (a->ph_lo <= nextk && nextk < a->ph_hi) { XcdBarrier b; b.bar = (unsigned*)(a->ws + WS_CTL) + CW_BAR; b.x = xb_xcc_id(); b.st = (volatile LAS unsigned*)(ldsp + MISC_OFF) + 8; xcd_barrier(b); }
}

__global__ void __launch_bounds__(NWAVES * 64, 2) hybrid_fwd(Args args_unused) {
    extern __shared__ __attribute__((aligned(16))) unsigned char lds[];
    LAS unsigned char* const ldsp = (LAS unsigned char*)lds;
    for (int u = threadIdx.x; u < (LDS_BYTES - LDSCTL_OFF) / 4; u += NWAVES * 64) ((LAS unsigned*)(ldsp + LDSCTL_OFF))[u] = 0u;
    __syncthreads();
    { CArgs a = get_args(); if (a->ph_hi - a->ph_lo > 1) (void)xcd_barrier_post((unsigned*)(a->ws + WS_CTL) + CW_BAR, (volatile LAS unsigned*)(ldsp + MISC_OFF) + 8); }
#define IN(k) ph_in(k)
#ifdef MK_DUP_PHASE
#define REPS(k) (((k) == MK_DUP_PHASE) ? MK_DUP_N : 1)
#else
#define REPS(k) 1
#endif
#define SEAM(k) seam((k) + 1, ldsp)
#define SEAMN(nk) seam((nk), ldsp)
#define PH_BEGIN const Frame F = make_frame(ldsp); CArgs args = get_args(); unsigned char* ws = args->ws; bf16* H = (bf16*)(ws + WS_H); bf16* XN = (bf16*)(ws + WS_XN); bf16* PROJ = (bf16*)(ws + WS_PROJ); bf16* XC = (bf16*)(ws + WS_XC); \
                 LAS unsigned char* ring = ldsp + RING_OFF; const int bx = (int)blockIdx.x; (void)H; (void)XN; (void)PROJ; (void)XC; (void)ring; (void)bx; (void)F;

    if (IN(0)) { PH_BEGIN for (int rep_ = 0; rep_ < REPS(0); ++rep_) { p0_prologue(F, args); } __syncthreads(); }
#ifdef MK_EXTRA_BAR
    for (int xb_ = 0; xb_ < MK_EXTRA_BAR; ++xb_) seam(1, ldsp);
#endif
    for (int l = 0; l < DEPTH; ++l) {
        const int pb = PH_LAYER0 + l * NPH;
        if (IN(pb + 0)) { PH_BEGIN
            for (int rep_ = 0; rep_ < REPS(pb + 0); ++rep_)
            if (l == 0) norm_phase<1, true>(F, args->in[I_X], args->in[I_NORM_MIX] + (size_t)l * DM, XN, args->in[I_W_IN] + (size_t)l * DM * DIN + NPROJ, DIN, args->in[I_FOX_BF] + l * 8, ws);
            else norm_phase<1, false>(F, H, args->in[I_NORM_MIX] + (size_t)l * DM, XN, args->in[I_W_IN] + (size_t)l * DM * DIN + NPROJ, DIN, args->in[I_FOX_BF] + l * 8, ws);
            SEAM(pb + 0); }
        if (IN(pb + 1)) {
            PH_BEGIN
            pg8::Gemm g{XN, DM, (const bf16*)(ws + WS_WIN) + (size_t)l * NPROJ * DM, 0, DM}; pg8::StaticOrder S; S.init(M, NPROJ, F.G, bx);
            pg8::EpiProj E{PROJ, PP, attn_body::C2};
            for (int rep_ = 0; rep_ < REPS(pb + 1); ++rep_) { pg8::gemm_phase<pg8::EpiProj, pg8::StaticOrder, true>(ring, g, S, E); }
            SEAM(pb + 1);
        }
        if (IN(pb + 2)) {
            PH_BEGIN
            for (int rep_ = 0; rep_ < REPS(pb + 2); ++rep_) { conv_phase(F, PROJ, args->in[I_CONV_W] + (size_t)l * 4 * 512, args->in[I_CONV_B] + (size_t)l * 512, XC); }
            fox_bounds_phase(F, PROJ, (float*)(ws + WS_KN), (float*)(ws + WS_QN));
            fox_cum_phase(F, (const float*)(ws + WS_LC), (const float*)(ws + WS_TOT), (float*)(ws + WS_CUMT));
            sgu_phase(F, PROJ, (const bf16*)(ws + WS_WSGU) + (size_t)l * 4 * 128 * 128, args->in[I_SGU_G] + (size_t)l * 512, args->in[I_SGU_B] + (size_t)l * 512);
            SEAMN(pb + 4);
        }
        if (IN(pb + 4)) { PH_BEGIN fox_plan_phase(F, (const float*)(ws + WS_CUMT), (const float*)(ws + WS_KN), (const float*)(ws + WS_QN), (int*)(ws + WS_TLO));
            for (int rep_ = 0; rep_ < REPS(pb + 4); ++rep_) lru_gate_phase(F, XC, (const bf16*)(ws + WS_WLRU) + (size_t)l * 1024 * 128, PROJ, args->in[I_RG_BA] + (size_t)l * 512, args->in[I_RG_BX] + (size_t)l * 512, args->in[I_RG_LAMBDA] + (size_t)l * 512, (float*)(ws + WS_LA), (float*)(ws + WS_LH), (float*)(ws + WS_LA8), (float*)(ws + WS_LH8)); SEAMN(pb + 6); }
        if (IN(pb + 6)) { PH_BEGIN lru_pass2(F, PROJ, (const float*)(ws + WS_LA), (const float*)(ws + WS_LH), (const float*)(ws + WS_LA8), (const float*)(ws + WS_LH8));
            __syncthreads(); }
        if (IN(pb + 7)) { { PH_BEGIN swa_phase(F, PROJ, args->in[I_SWA_SINKS] + l * 8); }
            PH_BEGIN unsigned* qc_ = (unsigned*)(ws + WS_CTL) + CW_ATTQ + 64 * l; int ut_ = -1, uo_ = 0;
            if (l == 0) {
                pg8::Gemm g{(const bf16*)(ws + WS_MEMN), DM, (const bf16*)(ws + WS_WKV), (long)1024 * DM, DM}; pg8::EpiBf16 E{(bf16*)(ws + WS_KV), 1024};
                ut_ = attn_queue_next(F, qc_); uo_ = 64;
#pragma unroll 1
                while (ut_ < 64) { pg8::OneUnit S{ut_, 8}; pg8::gemm_phase<pg8::EpiBf16, pg8::OneUnit, true>(ring, g, S, E); ut_ = attn_queue_next(F, qc_); }
            }
            (void)attn_phase(F, (char*)lds + RING_OFF, PROJ, (const float*)(ws + WS_CUMT), (const int*)(ws + WS_TLO), qc_, ut_, uo_);
            SEAM(pb + 7); }
        if (IN(pb + 8)) {
            PH_BEGIN
            pg8::GBParams gp{XN, PROJ, PP, C_AU, C_BY, C_CQ, C_DQ, (const bf16*)(ws + WS_WG) + (size_t)l * 4 * DM * DM, (const bf16*)(ws + WS_WB) + (size_t)l * 4 * DM * DM};
            pg8::StaticOrder S; S.init(M, DM, F.G, bx);
            pg8::EpiGateBranch<0> E{PROJ + C_G, PROJ + C_MG, PP, args->in[I_B_GATE] + (size_t)l * 4 * DM};
            pg8::gemm_gb_phase<pg8::EpiGateBranch<0>>(ring, gp, S, E);
#ifdef MK_GB_VAR
            if (l == 0) { pg8::EpiGateBranch<MK_GB_VAR> E2{(bf16*)args->out, (bf16*)args->out + 1024, 2048, args->in[I_B_GATE] + (size_t)l * 4 * DM};
                pg8::gemm_gb_phase<pg8::EpiGateBranch<MK_GB_VAR>>(ring, gp, S, E2); }
#endif
            SEAMN(pb + 15);
        }
        if (IN(pb + 15)) {
            PH_BEGIN
            pg8::Gemm g{PROJ + C_MG, PP, (const bf16*)(ws + WS_WOUT) + (size_t)l * DM * DM, 0, DM}; pg8::StaticOrder S; S.init(M, DM, F.G, bx);
            if (l == 0) { pg8::EpiResid<true, true> E{args->in[I_X], H, DM, (float*)(ws + WS_SSQ)}; for (int rep_ = 0; rep_ < REPS(pb + 15); ++rep_) { pg8::gemm_phase<pg8::EpiResid<true, true>, pg8::StaticOrder, true>(ring, g, S, E); } }
            else { pg8::EpiResid<false, true> E{nullptr, H, DM, (float*)(ws + WS_SSQ)}; pg8::gemm_phase<pg8::EpiResid<false, true>, pg8::StaticOrder, true>(ring, g, S, E); }
            SEAMN(pb + 17);
        }
#ifndef MK_SKIP_CROSS
        if (IN(pb + 17)) {
            PH_BEGIN
            pg8::Gemm g{H, DM, (const bf16*)(ws + WS_WQ) + (size_t)l * 512 * DM, 0, DM}; pg8::StaticOrder S; S.init(M, 512, F.G, bx);
            pg8::EpiBf16Rs E{PROJ, 512, (const float*)(ws + WS_SSQ)};
            for (int rep_ = 0; rep_ < REPS(pb + 17); ++rep_) { pg8::gemm_phase<pg8::EpiBf16Rs, pg8::StaticOrder, true>(ring, g, S, E); }
            SEAM(pb + 17);
        }
        if (IN(pb + 18)) { PH_BEGIN for (int rep_ = 0; rep_ < REPS(pb + 18); ++rep_) { xattn_phase(F, PROJ, (const bf16*)(ws + WS_KV) + (size_t)l * 2048 * 1024, rep_ ? (bf16*)args->out : PROJ); } SEAM(pb + 18); }
        if (IN(pb + 19)) {
            PH_BEGIN
            pg8::Gemm g{PROJ, 512, (const bf16*)(ws + WS_WOC) + (size_t)l * DM * 512, 0, 512}; pg8::StaticOrder S; S.init(M, DM, F.G, bx);
            pg8::EpiResid<false, true> E{nullptr, H, DM, (float*)(ws + WS_SSQ)};
            pg8::gemm_phase<pg8::EpiResid<false, true>, pg8::StaticOrder, true>(ring, g, S, E);
            SEAMN((l & 1) == 0 ? pb + 21 : pb + 20);
        }
#endif
        if ((l & 1) == 0) {
#ifndef MK_SKIP_FFN0
            if (IN(pb + 21)) {
                PH_BEGIN
                pg8::Gemm g{H, DM, (const bf16*)(ws + WS_W13) + (size_t)(l >> 1) * 2 * DFF * DM, 0, DM}; pg8::StaticOrder S; S.init(M, 2 * DFF, F.G, bx);
                pg8::EpiSwiglu<true> E{(bf16*)(ws + WS_ACT), DFF, (const float*)(ws + WS_SSQ)};
                for (int rep_ = 0; rep_ < REPS(pb + 21); ++rep_) { pg8::gemm_phase<pg8::EpiSwiglu<true>, pg8::StaticOrder, true>(ring, g, S, E); }
                SEAM(pb + 21);
            }
            if (IN(pb + 22)) {
                PH_BEGIN
                pg8::Gemm g{(const bf16*)(ws + WS_ACT), DFF, (const bf16*)(ws + WS_W2) + (size_t)(l >> 1) * DM * DFF, 0, DFF}; pg8::StaticOrder S; S.init(M, DM, F.G, bx);
                pg8::EpiResid<false> E{nullptr, H, DM, nullptr};
                pg8::gemm_phase<pg8::EpiResid<false>, pg8::StaticOrder, true>(ring, g, S, E);
#ifdef MK_W2_PROBE
                { pg8::EpiBf16 E2{(bf16*)args->out, DM}; pg8::gemm_phase<pg8::EpiBf16, pg8::StaticOrder, true>(ring, g, S, E2); }
#endif
                SEAMN(pb + NPH);
            }
#endif
        } else {
#ifndef MK_SKIP_FFN1
            if (IN(pb + 20)) { PH_BEGIN norm_phase<2, false>(F, H, args->in[I_NORM_FFN] + (size_t)l * DM, XN, args->in[I_ROUTER_W] + (size_t)(l >> 1) * DM * NE, NE, args->in[I_ROUTER_B] + (l >> 1) * NE, ws); for (int rep_ = 0; rep_ < REPS(pb + 20); ++rep_) { moe_convert_phase(F, args); } SEAM(pb + 20); }
            if (IN(pb + 21)) { PH_BEGIN for (int rep_ = 0; rep_ < REPS(pb + 21); ++rep_) { moe_build_phase(F, ws); } SEAM(pb + 21); }
            for (int k = 0; k < 2; ++k) {
                const int pk = pb + 22 + 3 * k;
                if (IN(pk + 1)) {
                    PH_BEGIN
                    const int ntl = ((const int*)(ws + WS_MOE + MOE_NT))[k]; const int* te = (const int*)(ws + WS_MOE + MOE_TILE_E) + k * 512;
                    const int ntl0 = ((const int*)(ws + WS_MOE + MOE_NT))[0]; const int rot = (k == 1) ? ((((ntl0 * 4) % F.G) + 7) & ~7) % F.G : 0;
                    pg8::Gemm g{XN, DM, (const bf16*)(ws + WS_MW13) + (size_t)(l >> 1) * NE * 2 * DFF * DM, (long)2 * DFF * DM, DM}; pg8::TableOrder S; S.init(ntl, 2 * DFF, F.G, (bx + F.G - rot) % F.G, te);
                    pg8::EpiSwiglu<false> E{(bf16*)(ws + WS_ACT), DFF, nullptr, (k == 1) ? (unsigned*)(ws + WS_CTL) + CW_G2DONE : nullptr, ntl0, (unsigned*)(ws + WS_CTL) + CW_BAR + XB_TMO};
                    pg8::gemm_phase_ga<pg8::EpiSwiglu<false>, pg8::TableOrder, true>(ring, g, S, E, (const int*)(ws + WS_MOE + MOE_S2T) + (size_t)k * SLOTS);
                    SEAM(pk + 1);
                }
                if (IN(pk + 2)) {
                    PH_BEGIN
                    const int ntl = ((const int*)(ws + WS_MOE + MOE_NT))[k]; const int* te = (const int*)(ws + WS_MOE + MOE_TILE_E) + k * 512;
                    pg8::Gemm g{(const bf16*)(ws + WS_ACT), DFF, (const bf16*)(ws + WS_MW2) + (size_t)(l >> 1) * NE * DM * DFF, (long)DM * DFF, DFF}; pg8::TableOrder S; S.init(ntl, DM, F.G, bx, te);
                    pg8::EpiMoeOut E{H, (const int*)(ws + WS_MOE + MOE_S2T) + (size_t)k * SLOTS, (const float*)(ws + WS_MOE + MOE_SW) + (size_t)k * SLOTS, (k == 0) ? (unsigned*)(ws + WS_CTL) + CW_G2DONE : nullptr};
                    pg8::gemm_phase<pg8::EpiMoeOut, pg8::TableOrder, true>(ring, g, S, E);
                    if (k == 0) __syncthreads(); else SEAM(pk + 2);
                }
            }
#endif
        }
    }
    if (IN(PH_FINAL)) { PH_BEGIN for (int rep_ = 0; rep_ < REPS(PH_FINAL); ++rep_) { final_norm_phase(F, H, args->out, args->in[I_NORM_FINAL], (const unsigned*)(ws + WS_CTL) + CW_BAR + XB_TMO); } }
#undef IN
#undef SEAM
#undef SEAMN
#undef PH_BEGIN
}

#ifdef MK_DUMP_COL
__global__ void dump_cols(const unsigned short* PROJ, float* out) {
    const size_t i = (size_t)blockIdx.x * blockDim.x + threadIdx.x; const size_t t = i >> 10; const int c = (int)(i & 1023);
    out[i] = __uint_as_float(((unsigned)PROJ[t * PP + MK_DUMP_COL + c]) << 16);
}
#endif
#ifdef MK_CHECK
static void dbg_launch(const Args& a, int stage, int l, float* d_out, void* d_ws, hipStream_t stream);
#endif
extern "C" void kernel_launch(void* const* d_in, const int* in_sizes, int n_in, void* d_out, int out_size, void* d_ws, size_t ws_size, hipStream_t stream) {
    static int grid = 0;
    if (grid == 0) {
        if (n_in != 33 || out_size != M * DM || ws_size < WS_END) { fprintf(stderr, "kernel_launch: unexpected shapes (n_in %d, out %d, ws %zu); nothing launched\n", n_in, out_size, ws_size); grid = -1; return; }
        { const long exp_[33] = {(long)M * DM, (long)BATCH * MEMLEN * DM, 2L * DM, 2L * DM * DIN, 2L * 512, 2L * 4 * 128 * 128, 2L * 4 * 128, 2L * 4 * 512, 2L * 512, 2L * 4 * 128 * 128, 2L * 512, 2L * 4 * 128 * 128, 2L * 512, 2L * 512, 2L * 8, 2L * 8,
              2L * 4 * 512 * DM, 2L * 4 * DM * DM, 2L * 4 * DM, 2L * DM * DM, 2L * DM, 2L * DM, 2L * DM * 512, 2L * DM * 1024, 2L * 512 * DM, 2L * DM, 1L * DM * 2 * DFF, 1L * DFF * DM, 1L * DM * NE, 1L * NE, 8L * DM * 2 * DFF, 8L * DFF * DM, (long)DM};
          for (int i = 0; i < 33; ++i) if ((long)in_sizes[i] != exp_[i]) { fprintf(stderr, "kernel_launch: input %d has %d elements, expected %ld; nothing launched\n", i, in_sizes[i], exp_[i]); grid = -1; return; } }
        int dev = 0, cus = 0, per_cu = 0;
        if (hipGetDevice(&dev) != hipSuccess || hipDeviceGetAttribute(&cus, hipDeviceAttributeMultiprocessorCount, dev) != hipSuccess) { grid = -1; return; }
        if (hipFuncSetAttribute((const void*)hybrid_fwd, hipFuncAttributeMaxDynamicSharedMemorySize, LDS_BYTES) != hipSuccess) { grid = -1; return; }
        if (hipOccupancyMaxActiveBlocksPerMultiprocessor(&per_cu, (const void*)hybrid_fwd, NWAVES * 64, LDS_BYTES) != hipSuccess || per_cu < 1) { fprintf(stderr, "kernel_launch: occupancy query reports %d\n", per_cu); }
        (void)hipGetLastError();
        grid = cus;
    }
    if (grid < 0) return;
    (void)hipMemsetAsync((char*)d_ws + WS_CTL, 0, CTL_ZERO_BYTES, stream);
    Args a{};
    for (int i = 0; i < 33; ++i) a.in[i] = (const float*)d_in[i];
    a.out = (float*)d_out; a.ws = (unsigned char*)d_ws;
#ifndef MK_SPLIT
#ifdef MK_PH_HI
    a.ph_lo = 0; a.ph_hi = MK_PH_HI;
    hipLaunchKernelGGL(hybrid_fwd, dim3(grid), dim3(NWAVES * 64), LDS_BYTES, stream, a);
#ifdef MK_CHECK
    dbg_launch(a, MK_CHECK, 0, (float*)d_out, d_ws, stream);
    return;
#endif
#ifdef MK_DUMP_COL
    hipLaunchKernelGGL(dump_cols, dim3(M * DM / 256), dim3(256), 0, stream, (const unsigned short*)((unsigned char*)d_ws + WS_PROJ), (float*)d_out);
    return;
#endif
#ifdef MK_NO_FINAL
    return;
#endif
    a.ph_lo = PH_FINAL; a.ph_hi = PH_FINAL + 1;
#else
    a.ph_lo = 0; a.ph_hi = PH_TOTAL;
#endif
    hipLaunchKernelGGL(hybrid_fwd, dim3(grid), dim3(NWAVES * 64), LDS_BYTES, stream, a);
#else
    for (int p = 0; p < PH_TOTAL; ++p) { a.ph_lo = p; a.ph_hi = p + 1; hipLaunchKernelGGL(hybrid_fwd, dim3(grid), dim3(NWAVES * 64), LDS_BYTES, stream, a); }
#endif
}
```
